# Optimizing an MI355X kernel written in HIP

```python
import jax, jax.numpy as jnp
from jax import lax
import numpy as np

D_MODEL = 1024
BATCH = 16
SEQ = 2048
DEPTH = 2

GRID_W = 64
ROPE_THETA = 10000.0
EPS = 1e-6
HEAD_DIM = 64
BLOCK = 128
WINDOW = 128

A_HEADS = 6
A_KV_HEADS = 2
B_HEADS = 6
B_KV_HEADS = 2
C_HEADS = 4
C_NOPE = 64
C_ROPE = 32
C_V = 64
C_Q_RANK = 192
C_KV_RANK = 128

A_W = A_HEADS * HEAD_DIM
A_KV_W = A_KV_HEADS * HEAD_DIM
B_W = B_HEADS * HEAD_DIM
B_KV_W = B_KV_HEADS * HEAD_DIM
C_W = C_HEADS * C_V
MIX_W = A_W + B_W + C_W

IN_SPLITS = (A_W, A_KV_W, A_KV_W, A_W,
             B_W, B_KV_W, B_KV_W, B_W,
             C_Q_RANK, C_KV_RANK, C_ROPE, C_W)
IN_COLS = 2656

kernel_name = "hybrid_parallel_heads_encoder"


def rms_norm(x, g):
    xf = x.astype(jnp.float32)
    y = xf * lax.rsqrt(jnp.mean(xf * xf, axis=-1, keepdims=True) + EPS)
    return (y * g.astype(jnp.float32)).astype(x.dtype)


def rope_tables(pos, dim):
    inv = ROPE_THETA ** (-jnp.arange(0, dim, 2, dtype=jnp.float32) / dim)
    ang = pos.astype(jnp.float32)[:, None] * inv[None, :]
    ang = jnp.concatenate([ang, ang], axis=-1)
    return jnp.cos(ang), jnp.sin(ang)


def apply_rope(x, cos, sin):
    x1, x2 = jnp.split(x, 2, axis=-1)
    rot = jnp.concatenate([-x2, x1], axis=-1)
    c = cos[None, :, None, :].astype(x.dtype)
    s = sin[None, :, None, :].astype(x.dtype)
    return x * c + rot * s


def apply_axial_rope(x, row_cs, col_cs):
    half = x.shape[-1] // 2
    xr = apply_rope(x[..., :half], row_cs[0], row_cs[1])
    xc = apply_rope(x[..., half:], col_cs[0], col_cs[1])
    return jnp.concatenate([xr, xc], axis=-1)


def dense_gqa_blocks(q, k, v, scale):
    bsz, s_len, n_h, d = q.shape
    n_kv = k.shape[2]
    grp = n_h // n_kv
    nb = s_len // BLOCK
    qb = q.reshape(bsz, nb, BLOCK, n_kv, grp, d).transpose(1, 0, 2, 3, 4, 5)

    def one_block(q_blk):
        s = jnp.einsum('bqhgd,bkhd->bhgqk', q_blk, k).astype(jnp.float32) * scale
        p = jax.nn.softmax(s, axis=-1).astype(v.dtype)
        return jnp.einsum('bhgqk,bkhd->bqhgd', p, v)

    o = lax.map(one_block, qb)
    return o.transpose(1, 0, 2, 3, 4, 5).reshape(bsz, s_len, n_h * d)


def windowed_sink_gqa(q, k, v, sink, scale):
    bsz, s_len, n_h, d = q.shape
    n_kv = k.shape[2]
    grp = n_h // n_kv
    nb = s_len // BLOCK
    qb = q.reshape(bsz, nb, BLOCK, n_kv, grp, d)
    pad = ((0, 0), (BLOCK, BLOCK), (0, 0), (0, 0))
    kp = jnp.pad(k, pad).reshape(bsz, nb + 2, BLOCK, n_kv, d)
    vp = jnp.pad(v, pad).reshape(bsz, nb + 2, BLOCK, n_kv, d)
    kb = jnp.concatenate([kp[:, :-2], kp[:, 1:-1], kp[:, 2:]], axis=2)
    vb = jnp.concatenate([vp[:, :-2], vp[:, 1:-1], vp[:, 2:]], axis=2)
    s = jnp.einsum('bnqhgd,bnkhd->bnhgqk', qb, kb).astype(jnp.float32) * scale
    blk = jnp.arange(nb)[:, None]
    qpos = blk * BLOCK + jnp.arange(BLOCK)[None, :]
    kpos = (blk - 1) * BLOCK + jnp.arange(3 * BLOCK)[None, :]
    valid = ((jnp.abs(qpos[:, :, None] - kpos[:, None, :]) <= WINDOW)
             & (kpos[:, None, :] >= 0) & (kpos[:, None, :] < s_len))
    s = jnp.where(valid[None, :, None, None], s, -1e30)
    sk = sink.astype(jnp.float32).reshape(1, 1, n_kv, grp, 1, 1)
    m = jnp.maximum(jnp.max(s, axis=-1, keepdims=True), sk)
    p = jnp.exp(s - m)
    denom = jnp.sum(p, axis=-1, keepdims=True) + jnp.exp(sk - m)
    p = (p / denom).astype(v.dtype)
    o = jnp.einsum('bnhgqk,bnkhd->bnqhgd', p, vb)
    return o.reshape(bsz, s_len, n_h * d)


def mla_blocks(q_nope, q_rope, k_nope, k_rope, v, scale):
    bsz, s_len, n_h, dn = q_nope.shape
    dr = q_rope.shape[-1]
    dv = v.shape[-1]
    nb = s_len // BLOCK
    qn = q_nope.reshape(bsz, nb, BLOCK, n_h, dn).transpose(1, 0, 2, 3, 4)
    qr = q_rope.reshape(bsz, nb, BLOCK, n_h, dr).transpose(1, 0, 2, 3, 4)

    def one_block(args):
        qn_b, qr_b = args
        s = (jnp.einsum('bqhd,bkhd->bhqk', qn_b, k_nope)
             + jnp.einsum('bqhr,bkr->bhqk', qr_b, k_rope)).astype(jnp.float32) * scale
        p = jax.nn.softmax(s, axis=-1).astype(v.dtype)
        return jnp.einsum('bhqk,bkhd->bqhd', p, v)

    o = lax.map(one_block, (qn, qr))
    return o.transpose(1, 0, 2, 3, 4).reshape(bsz, s_len, n_h * dv)


def hybrid_layer(x, g_norm, w_in, a_qn, a_kn, b_sink, c_qn, c_kvn, c_wuq, c_wukv, w_out,
                 axial_row, axial_col, rope_1d, rope_mla):
    bsz, s_len, _ = x.shape
    h = rms_norm(x, g_norm)
    z = jnp.einsum('bsd,dc->bsc', h, w_in)
    idx = np.cumsum(IN_SPLITS)[:-1].tolist()
    aq, ak, av, ag, bq, bk, bv, bg, cq, ckv, ckr, cg = jnp.split(z, idx, axis=-1)

    qa = rms_norm(aq.reshape(bsz, s_len, A_HEADS, HEAD_DIM), a_qn)
    ka = rms_norm(ak.reshape(bsz, s_len, A_KV_HEADS, HEAD_DIM), a_kn)
    qa = apply_axial_rope(qa, axial_row, axial_col)
    ka = apply_axial_rope(ka, axial_row, axial_col)
    va = av.reshape(bsz, s_len, A_KV_HEADS, HEAD_DIM)
    oa = dense_gqa_blocks(qa, ka, va, HEAD_DIM ** -0.5) * jax.nn.silu(ag)

    qb = apply_rope(bq.reshape(bsz, s_len, B_HEADS, HEAD_DIM), rope_1d[0], rope_1d[1])
    kb = apply_rope(bk.reshape(bsz, s_len, B_KV_HEADS, HEAD_DIM), rope_1d[0], rope_1d[1])
    vb = bv.reshape(bsz, s_len, B_KV_HEADS, HEAD_DIM)
    ob = windowed_sink_gqa(qb, kb, vb, b_sink, HEAD_DIM ** -0.5) * jax.nn.silu(bg)

    qc = jnp.einsum('bsr,rc->bsc', rms_norm(cq, c_qn), c_wuq).reshape(bsz, s_len, C_HEADS, C_NOPE + C_ROPE)
    qc_nope = qc[..., :C_NOPE]
    qc_rope = apply_rope(qc[..., C_NOPE:], rope_mla[0], rope_mla[1])
    kv = jnp.einsum('bsr,rc->bsc', rms_norm(ckv, c_kvn), c_wukv).reshape(bsz, s_len, C_HEADS, C_NOPE + C_V)
    kc_nope = kv[..., :C_NOPE]
    vc = kv[..., C_NOPE:]
    kc_rope = apply_rope(ckr[:, :, None, :], rope_mla[0], rope_mla[1])[:, :, 0, :]
    oc = mla_blocks(qc_nope, qc_rope, kc_nope, kc_rope, vc, (C_NOPE + C_ROPE) ** -0.5) * jax.nn.silu(cg)

    o = jnp.concatenate([oa, ob, oc], axis=-1)
    return x + jnp.einsum('bsm,md->bsd', o, w_out)


def setup_inputs(seed: int = 0) -> dict:
    key = jax.random.key(seed)
    ks = jax.random.split(key, 13)
    f32 = jnp.float32

    def nrm(k, shape, scale):
        return jax.random.normal(k, shape, f32) * scale

    return {
        "x": nrm(ks[0], (BATCH, SEQ, D_MODEL), 1.0),
        "norm_g": 1.0 + nrm(ks[1], (DEPTH, D_MODEL), 0.02),
        "w_in": nrm(ks[2], (DEPTH, D_MODEL, IN_COLS), D_MODEL ** -0.5),
        "a_q_norm": 1.0 + nrm(ks[3], (DEPTH, HEAD_DIM), 0.02),
        "a_k_norm": 1.0 + nrm(ks[4], (DEPTH, HEAD_DIM), 0.02),
        "b_sink": nrm(ks[5], (DEPTH, B_HEADS), 0.5),
        "c_q_norm": 1.0 + nrm(ks[6], (DEPTH, C_Q_RANK), 0.02),
        "c_kv_norm": 1.0 + nrm(ks[7], (DEPTH, C_KV_RANK), 0.02),
        "c_w_uq": nrm(ks[8], (DEPTH, C_Q_RANK, C_HEADS * (C_NOPE + C_ROPE)), C_Q_RANK ** -0.5),
        "c_w_ukv": nrm(ks[9], (DEPTH, C_KV_RANK, C_HEADS * (C_NOPE + C_V)), C_KV_RANK ** -0.5),
        "w_out": nrm(ks[10], (DEPTH, MIX_W, D_MODEL), MIX_W ** -0.5),
        "final_g": 1.0 + nrm(ks[11], (D_MODEL,), 0.02),
    }


def reference(x, norm_g, w_in, a_q_norm, a_k_norm, b_sink, c_q_norm, c_kv_norm, c_w_uq, c_w_ukv, w_out, final_g):
    s_len = x.shape[1]
    rows = s_len // GRID_W
    t = jnp.arange(s_len)
    row_idx = jnp.repeat(jnp.arange(rows), GRID_W)
    col_idx = jnp.tile(jnp.arange(GRID_W), rows)
    axial_row = rope_tables(row_idx, HEAD_DIM // 2)
    axial_col = rope_tables(col_idx, HEAD_DIM // 2)
    rope_1d = rope_tables(t, HEAD_DIM)
    rope_mla = rope_tables(t, C_ROPE)

    h = x
    for l in range(DEPTH):
        h = hybrid_layer(h, norm_g[l], w_in[l], a_q_norm[l], a_k_norm[l], b_sink[l],
                         c_q_norm[l], c_kv_norm[l], c_w_uq[l], c_w_ukv[l], w_out[l],
                         axial_row, axial_col, rope_1d, rope_mla)
    return rms_norm(h, final_g)
```

```cpp
#include <hip/hip_runtime.h>
#include <hip/hip_cooperative_groups.h>
#include <stdint.h>
#include <cstdio>
namespace cg = cooperative_groups;

#ifndef MK_COOP
#define MK_COOP 1
#endif

#define DI __device__ __forceinline__
typedef unsigned short bf16_t;
typedef short bf16x8 __attribute__((ext_vector_type(8)));
typedef float f32x16 __attribute__((ext_vector_type(16)));
typedef unsigned u32x4 __attribute__((ext_vector_type(4)));
typedef unsigned u32x2 __attribute__((ext_vector_type(2)));
typedef __bf16 bf2_t __attribute__((ext_vector_type(2)));
typedef float f2_t __attribute__((ext_vector_type(2)));

constexpr int D_MODEL = 1024, SEQ = 2048, NBATCH = 16, NTOK = NBATCH * SEQ;
constexpr int IN_COLS = 2656, IN_PAD = 2688;
constexpr int OFF_AQ = 0, OFF_AK = 384, OFF_AV = 512, OFF_AG = 640, OFF_BQ = 1024, OFF_BK = 1408, OFF_BV = 1536,
              OFF_BG = 1664, OFF_CQ = 2048, OFF_CKV = 2240, OFF_CKR = 2368, OFF_CG = 2400;
constexpr int T64_OFF = 2048 * 16;
constexpr float EPS = 1e-6f;
constexpr float LOG2E = 1.4426950408889634f;

struct Params {
    const float *x, *norm_g, *w_in, *a_qn, *a_kn, *b_sink, *c_qn, *c_kvn, *c_wuq, *c_wukv, *w_out, *final_g;
    float* out;
    bf16_t *xb, *z, *qc, *kc, *vtA, *vtB, *vtC, *winT, *woutT, *wuqT, *wukvT;
    float2 *t32;
};

DI unsigned pk2(float lo, float hi) { f2_t v = {lo, hi}; return __builtin_bit_cast(unsigned, __builtin_convertvector(v, bf2_t)); }
DI float bflo(unsigned u) { return __uint_as_float(u << 16); }
DI float bfhi(unsigned u) { return __uint_as_float(u & 0xffff0000u); }
DI void unpack8(const u32x4& raw, float* v) {
#pragma unroll
    for (int k = 0; k < 4; ++k) { v[2 * k] = bflo(raw[k]); v[2 * k + 1] = bfhi(raw[k]); }
}
DI u32x4 pack8(const float* v) { u32x4 o; o[0] = pk2(v[0], v[1]); o[1] = pk2(v[2], v[3]); o[2] = pk2(v[4], v[5]); o[3] = pk2(v[6], v[7]); return o; }
DI float wave_sum(float v) {
#pragma unroll
    for (int o = 32; o >= 1; o >>= 1) v += __shfl_xor(v, o);
    return v;
}
DI int opaque_tid() { int t = threadIdx.x; asm volatile("" : "+v"(t)); return t; }
DI int crow(int i, int h) { return (i & 3) + 8 * (i >> 2) + 4 * h; }
#define MFMA32(a, b, c) __builtin_amdgcn_mfma_f32_32x32x16_bf16((a), (b), (c), 0, 0, 0)

template <class F> DI void for_items(int total, F f) {
    if ((gridDim.x & 7) == 0 && (total & 7) == 0) {
        const int x = blockIdx.x & 7, j = blockIdx.x >> 3, nb = gridDim.x >> 3, per = total >> 3;
        for (int t = j; t < per; t += nb) f(x * per + t);
    } else {
        for (int t = blockIdx.x; t < total; t += gridDim.x) f(t);
    }
}

DI void transpose_convert(const float* __restrict__ W, const float* __restrict__ scale, bf16_t* __restrict__ Wt, int K, int N, int Npad, long gtid, long gthreads) {
    const int KC = K >> 3;
    const long total = (long)Npad * KC;
    for (long it = gtid; it < total; it += gthreads) {
        const int n = (int)(it % Npad), kc = (int)(it / Npad);
        u32x4 o = {0u, 0u, 0u, 0u};
        if (n < N) {
            float v[8];
#pragma unroll
            for (int j = 0; j < 8; ++j) { const int k = kc * 8 + j; float w = W[(long)k * N + n]; if (scale) w *= scale[k]; v[j] = w; }
            o = pack8(v);
        }
        *(u32x4*)(Wt + (long)n * K + kc * 8) = o;
    }
}

DI void phase_prep(const Params& P) {
    const long gtid = (long)blockIdx.x * blockDim.x + opaque_tid(), gth = (long)gridDim.x * blockDim.x;
    for (int l = 0; l < 2; ++l) {
        transpose_convert(P.w_in + (long)l * 1024 * IN_COLS, P.norm_g + l * 1024, P.winT + (long)l * IN_PAD * 1024, 1024, IN_COLS, IN_PAD, gtid, gth);
        transpose_convert(P.w_out + (long)l * 1024 * 1024, nullptr, P.woutT + (long)l * 1024 * 1024, 1024, 1024, 1024, gtid, gth);
        transpose_convert(P.c_wuq + (long)l * 192 * 384, P.c_qn + l * 192, P.wuqT + (long)l * 384 * 192, 192, 384, 384, gtid, gth);
        transpose_convert(P.c_wukv + (long)l * 128 * 512, P.c_kvn + l * 128, P.wukvT + (long)l * 512 * 128, 128, 512, 512, gtid, gth);
    }
    for (long it = gtid; it < 2048 * 16; it += gth) {
        const int p = (int)(it >> 4), i = (int)(it & 15);
        const float inv = powf(10000.0f, -(float)i / 16.0f);
        const float ang = (float)p * inv;
        float s, c; sincosf(ang, &s, &c);
        P.t32[it] = make_float2(c, s);
    }
    for (long it = gtid; it < 2048 * 32; it += gth) {
        const int p = (int)(it >> 5), i = (int)(it & 31);
        const float inv = powf(10000.0f, -(float)i / 32.0f);
        const float ang = (float)p * inv;
        float s, c; sincosf(ang, &s, &c);
        P.t32[T64_OFF + it] = make_float2(c, s);
    }
}

template <bool FINAL> DI void phase_norm(const float* xin, bf16_t* xb, float* outp, const float* g) {
    const int tid = opaque_tid(), lane = tid & 63;
    const int gw = blockIdx.x * 4 + (tid >> 6), nw = gridDim.x * 4;
    for (int row = gw; row < NTOK; row += nw) {
        const float4* p = (const float4*)(xin + (long)row * 1024);
        float4 v[4]; float ss = 0.f;
#pragma unroll
        for (int i = 0; i < 4; ++i) { v[i] = p[lane + 64 * i]; ss += v[i].x * v[i].x + v[i].y * v[i].y + v[i].z * v[i].z + v[i].w * v[i].w; }
        ss = wave_sum(ss);
        const float rinv = rsqrtf(ss * (1.0f / 1024.0f) + EPS);
#pragma unroll
        for (int i = 0; i < 4; ++i) {
            if (FINAL) {
                const float4 gg = ((const float4*)g)[lane + 64 * i];
                float4 o; o.x = v[i].x * rinv * gg.x; o.y = v[i].y * rinv * gg.y; o.z = v[i].z * rinv * gg.z; o.w = v[i].w * rinv * gg.w;
                ((float4*)(outp + (long)row * 1024))[lane + 64 * i] = o;
            } else {
                u32x2 o; o[0] = pk2(v[i].x * rinv, v[i].y * rinv); o[1] = pk2(v[i].z * rinv, v[i].w * rinv);
                *(u32x2*)(xb + (long)row * 1024 + (lane + 64 * i) * 4) = o;
            }
        }
    }
}

struct GemmArgs { const bf16_t* A; int lda; const bf16_t* Bt; int ldb; int K; };

template <class Epi>
DI void gemm_tile(const GemmArgs& g, int m0, int n0, char* lds, const Epi& epi) {
    const int tid = opaque_tid(), lane = tid & 63, wid = tid >> 6, wm = wid >> 1, wn = wid & 1;
    const int r = lane & 31, h = lane >> 5;
    f32x16 acc[2][2];
#pragma unroll
    for (int a = 0; a < 2; ++a)
#pragma unroll
        for (int b = 0; b < 2; ++b)
#pragma unroll
            for (int i = 0; i < 16; ++i) acc[a][b][i] = 0.f;
    const int srow = tid >> 3, sch = tid & 7;
    const bf16_t* ap = g.A + (long)(m0 + srow) * g.lda + sch * 8;
    const bf16_t* bp = g.Bt + (long)(n0 + srow) * g.ldb + sch * 8;
    const int soff = srow * 128 + ((sch ^ ((srow >> 1) & 7)) << 4);
    u32x4 ra[4], rb[4];
    const int nk = g.K >> 6;
#pragma unroll
    for (int i = 0; i < 4; ++i) { ra[i] = *(const u32x4*)(ap + (long)(32 * i) * g.lda); rb[i] = *(const u32x4*)(bp + (long)(32 * i) * g.ldb); }
#pragma unroll
    for (int i = 0; i < 4; ++i) { *(u32x4*)(lds + soff + i * 4096) = ra[i]; *(u32x4*)(lds + 16384 + soff + i * 4096) = rb[i]; }
    __syncthreads();
    int arow[2], brow[2];
#pragma unroll
    for (int i = 0; i < 2; ++i) { arow[i] = wm * 64 + i * 32 + r; brow[i] = wn * 64 + i * 32 + r; }
    for (int kt = 0; kt < nk; ++kt) {
        if (kt + 1 < nk) {
#pragma unroll
            for (int i = 0; i < 4; ++i) { ra[i] = *(const u32x4*)(ap + (long)(32 * i) * g.lda + (kt + 1) * 64); rb[i] = *(const u32x4*)(bp + (long)(32 * i) * g.ldb + (kt + 1) * 64); }
        }
        const char* la = lds + (kt & 1) * 32768;
        const char* lb = la + 16384;
#pragma unroll
        for (int s = 0; s < 4; ++s) {
            bf16x8 af[2], bfr[2];
#pragma unroll
            for (int i = 0; i < 2; ++i) {
                af[i] = *(const bf16x8*)(la + arow[i] * 128 + (((2 * s + h) ^ ((arow[i] >> 1) & 7)) << 4));
                bfr[i] = *(const bf16x8*)(lb + brow[i] * 128 + (((2 * s + h) ^ ((brow[i] >> 1) & 7)) << 4));
            }
#pragma unroll
            for (int a = 0; a < 2; ++a)
#pragma unroll
                for (int b = 0; b < 2; ++b) acc[a][b] = MFMA32(af[a], bfr[b], acc[a][b]);
        }
        if (kt + 1 < nk) {
            char* ls = lds + ((kt + 1) & 1) * 32768;
#pragma unroll
            for (int i = 0; i < 4; ++i) { *(u32x4*)(ls + soff + i * 4096) = ra[i]; *(u32x4*)(ls + 16384 + soff + i * 4096) = rb[i]; }
        }
        __syncthreads();
    }
    epi(acc, m0 + wm * 64, n0 + wn * 64, r, h);
}

DI void store_vt(bf16_t* dst  , const f32x16& a, int h) {
#pragma unroll
    for (int g4 = 0; g4 < 4; ++g4) {
        u32x2 o; o[0] = pk2(a[4 * g4], a[4 * g4 + 1]); o[1] = pk2(a[4 * g4 + 2], a[4 * g4 + 3]);
        *(u32x2*)(dst + 8 * g4 + 4 * h) = o;
    }
}

struct EpiZ {
    bf16_t *z, *vtA, *vtB;
    DI void operator()(const f32x16 (&acc)[2][2], int mw, int nw, int r, int h) const {
        const int ntile = nw >> 7;
        if (ntile == 4 || ntile == 12) {
            bf16_t* vt = (ntile == 4) ? vtA : vtB;
#pragma unroll
            for (int mi = 0; mi < 2; ++mi)
#pragma unroll
                for (int ni = 0; ni < 2; ++ni) {
                    const int c = (nw & 127) + ni * 32 + r, tok0 = mw + mi * 32, b = tok0 >> 11, t0 = tok0 & 2047;
                    store_vt(vt + ((long)((b * 2 + (c >> 6)) * 64 + (c & 63))) * SEQ + t0, acc[mi][ni], h);
                }
        } else {
#pragma unroll
            for (int mi = 0; mi < 2; ++mi)
#pragma unroll
                for (int ni = 0; ni < 2; ++ni) {
                    const int col = nw + ni * 32 + r;
                    if (col < IN_COLS) {
#pragma unroll
                        for (int i = 0; i < 16; ++i) z[(long)(mw + mi * 32 + crow(i, h)) * IN_COLS + col] = (bf16_t)(pk2(acc[mi][ni][i], 0.f) & 0xffffu);
                    }
                }
        }
    }
};
struct EpiQC {
    bf16_t* qc;
    DI void operator()(const f32x16 (&acc)[2][2], int mw, int nw, int r, int h) const {
#pragma unroll
        for (int mi = 0; mi < 2; ++mi)
#pragma unroll
            for (int ni = 0; ni < 2; ++ni) {
                const int col = nw + ni * 32 + r;
#pragma unroll
                for (int i = 0; i < 16; ++i) qc[(long)(mw + mi * 32 + crow(i, h)) * 384 + col] = (bf16_t)(pk2(acc[mi][ni][i], 0.f) & 0xffffu);
            }
    }
};
struct EpiKV {
    bf16_t *kc, *vtC;
    DI void operator()(const f32x16 (&acc)[2][2], int mw, int nw, int r, int h) const {
        const int head = nw >> 7;
        if (nw & 64) {
#pragma unroll
            for (int mi = 0; mi < 2; ++mi)
#pragma unroll
                for (int ni = 0; ni < 2; ++ni) {
                    const int c = ni * 32 + r, tok0 = mw + mi * 32, b = tok0 >> 11, t0 = tok0 & 2047;
                    store_vt(vtC + ((long)((b * 4 + head) * 64 + c)) * SEQ + t0, acc[mi][ni], h);
                }
        } else {
#pragma unroll
            for (int mi = 0; mi < 2; ++mi)
#pragma unroll
                for (int ni = 0; ni < 2; ++ni) {
                    const int col = head * 64 + ni * 32 + r;
#pragma unroll
                    for (int i = 0; i < 16; ++i) kc[(long)(mw + mi * 32 + crow(i, h)) * 256 + col] = (bf16_t)(pk2(acc[mi][ni][i], 0.f) & 0xffffu);
                }
        }
    }
};
struct EpiOut {
    const float* xin; float* out;
    DI void operator()(const f32x16 (&acc)[2][2], int mw, int nw, int r, int h) const {
#pragma unroll
        for (int mi = 0; mi < 2; ++mi)
#pragma unroll
            for (int ni = 0; ni < 2; ++ni) {
                const int col = nw + ni * 32 + r;
#pragma unroll
                for (int i = 0; i < 16; ++i) { const long o = (long)(mw + mi * 32 + crow(i, h)) * 1024 + col; out[o] = xin[o] + acc[mi][ni][i]; }
            }
    }
};

DI void phase_kprep(const Params& P, int l) {
    const int tid = opaque_tid(), lane = tid & 63;
    const int gw = blockIdx.x * 4 + (tid >> 6), nw = gridDim.x * 4;
    for (int tok = gw; tok < NTOK; tok += nw) {
        const int t = tok & 2047;
        bf16_t* zr = P.z + (long)tok * IN_COLS;
        {
            const int grp = (lane < 16) ? 0 : (lane < 32) ? 1 : 2;
            const int c = (grp == 2) ? (lane & 3) : (lane & 7);
            bf16_t* ptr = (grp == 0) ? zr + OFF_AK + lane * 8 : (grp == 1) ? zr + OFF_BK + (lane - 16) * 8 : zr + OFF_CKR + (lane & 3) * 8;
            const u32x4 raw = *(const u32x4*)ptr;
            float v[8]; unpack8(raw, v);
            float ss = 0.f;
#pragma unroll
            for (int j = 0; j < 8; ++j) ss += v[j] * v[j];
            ss += __shfl_xor(ss, 1); ss += __shfl_xor(ss, 2); ss += __shfl_xor(ss, 4);
            if (grp == 0) {
                const float rinv = rsqrtf(ss * (1.0f / 64.0f) + EPS);
                const float* kn = P.a_kn + l * 64 + c * 8;
#pragma unroll
                for (int j = 0; j < 8; ++j) v[j] = v[j] * rinv * kn[j];
            }
            float pv[8];
#pragma unroll
            for (int j = 0; j < 8; ++j) { const float p2 = __shfl_xor(v[j], 2), p4 = __shfl_xor(v[j], 4); pv[j] = (grp == 1) ? p4 : p2; }
            int tidx; bool first;
            if (grp == 0) { const int pos = (c < 4) ? (t >> 6) : (t & 63); tidx = pos * 16 + (c & 1) * 8; first = !(c & 2); }
            else if (grp == 1) { tidx = T64_OFF + t * 32 + (c & 3) * 8; first = (c < 4); }
            else { tidx = t * 16 + (c & 1) * 8; first = !(c & 2); }
            const float2* tb = P.t32 + tidx;
            float o[8];
#pragma unroll
            for (int j = 0; j < 8; ++j) { const float2 cs = tb[j]; o[j] = v[j] * cs.x + (first ? -pv[j] : pv[j]) * cs.y; }
            if (lane < 36) *(u32x4*)ptr = pack8(o);
        }
        {
            const int hl = lane & 31;
            const bool lo = lane < 32;
            const bool valid = lo ? (hl < 24) : (hl < 16);
            bf16_t* ptr = lo ? zr + OFF_CQ + (valid ? hl : 0) * 8 : zr + OFF_CKV + (valid ? hl : 0) * 8;
            const u32x4 raw = *(const u32x4*)ptr;
            float v[8]; unpack8(raw, v);
            float ss = 0.f;
            if (valid) {
#pragma unroll
                for (int j = 0; j < 8; ++j) ss += v[j] * v[j];
            }
            ss += __shfl_xor(ss, 1); ss += __shfl_xor(ss, 2); ss += __shfl_xor(ss, 4); ss += __shfl_xor(ss, 8); ss += __shfl_xor(ss, 16);
            const float rinv = rsqrtf(ss * (lo ? (1.0f / 192.0f) : (1.0f / 128.0f)) + EPS);
#pragma unroll
            for (int j = 0; j < 8; ++j) v[j] *= rinv;
            if (valid) *(u32x4*)ptr = pack8(v);
        }
    }
}

template <int TYPE, int NQT>
DI void attn_item(const Params& P, int l, int b, int head, int kvh, int qb, char* lds) {
    constexpr int NS = (TYPE == 2) ? 6 : 4;
    const int tid = opaque_tid(), lane = tid & 63, wid = tid >> 6, r = lane & 31, h = lane >> 5;
    const int q0 = qb * (128 * NQT) + wid * (32 * NQT);
    const float sc = ((TYPE == 2) ? 0.10206207261596577f : 0.125f) * LOG2E;

    bf16x8 qf[NQT][NS];
#pragma unroll
    for (int qt = 0; qt < NQT; ++qt) {
        const int tq = q0 + qt * 32 + r;
        const long tok = (long)b * SEQ + tq;
        const bf16_t* src = (TYPE == 0) ? P.z + tok * IN_COLS + OFF_AQ + head * 64 : (TYPE == 1) ? P.z + tok * IN_COLS + OFF_BQ + head * 64 : P.qc + tok * 384 + head * 96;
        float qv[NS][8];
#pragma unroll
        for (int s = 0; s < NS; ++s) { const u32x4 raw = *(const u32x4*)(src + 16 * s + 8 * h); unpack8(raw, qv[s]); }
        if (TYPE == 0) {
            float ss = 0.f;
#pragma unroll
            for (int s = 0; s < 4; ++s)
#pragma unroll
                for (int j = 0; j < 8; ++j) ss += qv[s][j] * qv[s][j];
            ss += __shfl_xor(ss, 32);
            const float rinv = rsqrtf(ss * (1.0f / 64.0f) + EPS);
#pragma unroll
            for (int s = 0; s < 4; ++s)
#pragma unroll
                for (int j = 0; j < 8; ++j) qv[s][j] *= rinv * P.a_qn[l * 64 + 16 * s + 8 * h + j];
            const float2* tr = P.t32 + (tq >> 6) * 16 + 8 * h;
            const float2* tc = P.t32 + (tq & 63) * 16 + 8 * h;
#pragma unroll
            for (int j = 0; j < 8; ++j) {
                const float2 a = tr[j], c2 = tc[j];
                const float x0 = qv[0][j], x1 = qv[1][j], y0 = qv[2][j], y1 = qv[3][j];
                qv[0][j] = x0 * a.x - x1 * a.y; qv[1][j] = x1 * a.x + x0 * a.y;
                qv[2][j] = y0 * c2.x - y1 * c2.y; qv[3][j] = y1 * c2.x + y0 * c2.y;
            }
        } else if (TYPE == 1) {
            const float2* t0 = P.t32 + T64_OFF + tq * 32 + 8 * h;
#pragma unroll
            for (int j = 0; j < 8; ++j) {
                const float2 a = t0[j], c2 = t0[16 + j];
                const float x0 = qv[0][j], x1 = qv[2][j], y0 = qv[1][j], y1 = qv[3][j];
                qv[0][j] = x0 * a.x - x1 * a.y; qv[2][j] = x1 * a.x + x0 * a.y;
                qv[1][j] = y0 * c2.x - y1 * c2.y; qv[3][j] = y1 * c2.x + y0 * c2.y;
            }
        } else {
            const float2* t0 = P.t32 + tq * 16 + 8 * h;
#pragma unroll
            for (int j = 0; j < 8; ++j) {
                const float2 a = t0[j];
                const float x0 = qv[NS - 2][j], x1 = qv[NS - 1][j];
                qv[NS - 2][j] = x0 * a.x - x1 * a.y; qv[NS - 1][j] = x1 * a.x + x0 * a.y;
            }
        }
#pragma unroll
        for (int s = 0; s < NS; ++s) {
            float tmp[8];
#pragma unroll
            for (int j = 0; j < 8; ++j) tmp[j] = qv[s][j] * sc;
            qf[qt][s] = __builtin_bit_cast(bf16x8, pack8(tmp));
        }
    }

    const bf16_t* kbase; long kstride; const bf16_t* vbase; const bf16_t* krbase = nullptr;
    if (TYPE == 0) { kbase = P.z + (long)b * SEQ * IN_COLS + OFF_AK + kvh * 64; kstride = IN_COLS; vbase = P.vtA + (long)((b * 2 + kvh) * 64) * SEQ; }
    else if (TYPE == 1) { kbase = P.z + (long)b * SEQ * IN_COLS + OFF_BK + kvh * 64; kstride = IN_COLS; vbase = P.vtB + (long)((b * 2 + kvh) * 64) * SEQ; }
    else { kbase = P.kc + (long)b * SEQ * 256 + head * 64; kstride = 256; vbase = P.vtC + (long)((b * 4 + head) * 64) * SEQ; krbase = P.z + (long)b * SEQ * IN_COLS + OFF_CKR; }
    int kt_lo = 0, kt_hi = 32;
    if (TYPE == 1) { kt_lo = qb * (2 * NQT) - 2; if (kt_lo < 0) kt_lo = 0; kt_hi = qb * (2 * NQT) + 2 * NQT + 2; if (kt_hi > 32) kt_hi = 32; }

    const int srow = tid >> 3, sch = tid & 7;
    const int soff = srow * 128 + ((sch ^ ((srow >> 1) & 7)) << 4);
    const int krow_s = tid >> 2, kch_s = tid & 3;
    const int kroff = krow_s * 64 + ((kch_s ^ ((krow_s >> 2) & 3)) << 4);
    const bf16_t* kp = kbase + (long)srow * kstride + sch * 8;
    const bf16_t* vp = vbase + (long)srow * SEQ + sch * 8;
    const bf16_t* krp = (TYPE == 2) ? krbase + (long)krow_s * IN_COLS + kch_s * 8 : nullptr;
    u32x4 rs[2], rkr;
    constexpr int BUF = 20480;
#define ATT_GLOAD_K(kt_)                                                                                 \
    { _Pragma("unroll") for (int i = 0; i < 2; ++i) rs[i] = *(const u32x4*)(kp + (long)((kt_) * 64 + 32 * i) * kstride); }
#define ATT_LSTORE_K(buf_)                                                                               \
    { char* ls_ = lds + (buf_) * BUF; _Pragma("unroll") for (int i = 0; i < 2; ++i) *(u32x4*)(ls_ + soff + i * 4096) = rs[i]; }
#define ATT_GLOAD_V(kt_)                                                                                 \
    {                                                                                                    \
        _Pragma("unroll") for (int i = 0; i < 2; ++i) rs[i] = *(const u32x4*)(vp + (long)(32 * i) * SEQ + (kt_) * 64); \
        if (TYPE == 2) rkr = *(const u32x4*)(krp + (long)((kt_) * 64) * IN_COLS);                        \
    }
#define ATT_LSTORE_V(buf_)                                                                               \
    {                                                                                                    \
        char* ls_ = lds + (buf_) * BUF;                                                                  \
        _Pragma("unroll") for (int i = 0; i < 2; ++i) *(u32x4*)(ls_ + 8192 + soff + i * 4096) = rs[i];   \
        if (TYPE == 2) *(u32x4*)(ls_ + 16384 + kroff) = rkr;                                             \
    }

    const int pr = (r & 0x13) | ((r & 4) << 1) | ((r & 8) >> 1);
    int koff[NS];
#pragma unroll
    for (int s = 0; s < NS; ++s) {
        if (s < 4) koff[s] = pr * 128 + (((2 * s + h) ^ ((pr >> 1) & 7)) << 4);
        else koff[s] = 16384 + pr * 64 + (((2 * (s - 4) + h) ^ ((pr >> 2) & 3)) << 4);
    }
    int voff[2][2];
#pragma unroll
    for (int c = 0; c < 2; ++c)
#pragma unroll
        for (int s2 = 0; s2 < 2; ++s2) voff[c][s2] = 8192 + r * 128 + (((4 * c + 2 * s2 + h) ^ ((r >> 1) & 7)) << 4);

    f32x16 O[NQT][2];
#pragma unroll
    for (int a = 0; a < NQT; ++a)
#pragma unroll
        for (int d = 0; d < 2; ++d)
#pragma unroll
            for (int i = 0; i < 16; ++i) O[a][d][i] = 0.f;
    float m[NQT], lsum[NQT];
#pragma unroll
    for (int a = 0; a < NQT; ++a) {
        if (TYPE == 1) { m[a] = P.b_sink[l * 6 + head] * LOG2E; lsum[a] = (h == 0) ? 1.f : 0.f; }
        else { m[a] = -INFINITY; lsum[a] = 0.f; }
    }

    ATT_GLOAD_K(kt_lo);
    ATT_LSTORE_K(0);
    ATT_GLOAD_V(kt_lo);
    ATT_LSTORE_V(0);
    __syncthreads();
    for (int kt = kt_lo; kt < kt_hi; ++kt) {
        const int it = kt - kt_lo;
        const bool more = kt + 1 < kt_hi;
        const char* lb = lds + (it & 1) * BUF;
        bool active = true;
        if (TYPE == 1) active = (kt * 64 + 63 >= q0 - 128) && (kt * 64 <= q0 + 32 * NQT - 1 + 128);
#pragma unroll
        for (int c = 0; c < 2; ++c) {
            if (more) { if (c == 0) ATT_GLOAD_K(kt + 1) else ATT_GLOAD_V(kt + 1) }
            if (active) {
#pragma unroll
                for (int qt = 0; qt < NQT; ++qt) {
                    f32x16 S;
#pragma unroll
                    for (int i = 0; i < 16; ++i) S[i] = 0.f;
#pragma unroll
                    for (int s = 0; s < NS; ++s) {
                        const bf16x8 kf = *(const bf16x8*)(lb + koff[s] + c * ((s < 4) ? 4096 : 2048));
                        S = MFMA32(kf, qf[qt][s], S);
                    }
                    if (TYPE == 1) {
                        const int qpos = q0 + qt * 32 + r;
                        const int kb0 = kt * 64 + c * 32 + 8 * h;
#pragma unroll
                        for (int i = 0; i < 16; ++i) {
                            const int key = kb0 + (i & 3) + 4 * ((i >> 2) & 1) + 16 * (i >> 3);
                            const int d = qpos - key;
                            if (d > 128 || d < -128) S[i] = -1e30f;
                        }
                    }
                    float mx = S[0];
#pragma unroll
                    for (int i = 1; i < 16; ++i) mx = fmaxf(mx, S[i]);
                    mx = fmaxf(mx, __shfl_xor(mx, 32));
                    const float mnew = fmaxf(m[qt], mx);
                    const float alpha = __builtin_amdgcn_exp2f(m[qt] - mnew);
                    m[qt] = mnew;
                    float rs = 0.f;
#pragma unroll
                    for (int i = 0; i < 16; ++i) { const float p = __builtin_amdgcn_exp2f(S[i] - mnew); S[i] = p; rs += p; }
                    lsum[qt] = lsum[qt] * alpha + rs;
#pragma unroll
                    for (int d = 0; d < 2; ++d)
#pragma unroll
                        for (int i = 0; i < 16; ++i) O[qt][d][i] *= alpha;
#pragma unroll
                    for (int s2 = 0; s2 < 2; ++s2) {
                        u32x4 pp;
#pragma unroll
                        for (int k = 0; k < 4; ++k) pp[k] = pk2(S[8 * s2 + 2 * k], S[8 * s2 + 2 * k + 1]);
                        const bf16x8 pf = __builtin_bit_cast(bf16x8, pp);
#pragma unroll
                        for (int dvt = 0; dvt < 2; ++dvt) {
                            const bf16x8 vf = *(const bf16x8*)(lb + voff[c][s2] + dvt * 4096);
                            O[qt][dvt] = MFMA32(vf, pf, O[qt][dvt]);
                        }
                    }
                }
            }
            if (more) { if (c == 0) ATT_LSTORE_K((it + 1) & 1) else ATT_LSTORE_V((it + 1) & 1) }
        }
        __syncthreads();
    }

    bf16_t* og = P.xb;
    {
        const int tid2 = opaque_tid(), r2 = tid2 & 31, h2 = (tid2 >> 5) & 1;
        const int q02 = qb * (128 * NQT) + (tid2 >> 6) * (32 * NQT);
#pragma unroll
        for (int qt = 0; qt < NQT; ++qt) {
            const float lt = lsum[qt] + __shfl_xor(lsum[qt], 32);
            const float inv = 1.0f / lt;
            const long tok = (long)b * SEQ + q02 + qt * 32 + r2;
            const bf16_t* gp = P.z + tok * IN_COLS + ((TYPE == 0) ? OFF_AG : (TYPE == 1) ? OFF_BG : OFF_CG) + head * 64;
            bf16_t* op = og + tok * 1024 + ((TYPE == 0) ? 0 : (TYPE == 1) ? 384 : 768) + head * 64;
#pragma unroll
            for (int dvt = 0; dvt < 2; ++dvt)
#pragma unroll
                for (int g4 = 0; g4 < 4; ++g4) {
                    const int dv = dvt * 32 + 8 * g4 + 4 * h2;
                    const u32x2 graw = *(const u32x2*)(gp + dv);
                    const float gv0 = bflo(graw[0]), gv1 = bfhi(graw[0]), gv2 = bflo(graw[1]), gv3 = bfhi(graw[1]);
                    const float o0 = O[qt][dvt][4 * g4 + 0] * inv * (gv0 / (1.0f + __expf(-gv0)));
                    const float o1 = O[qt][dvt][4 * g4 + 1] * inv * (gv1 / (1.0f + __expf(-gv1)));
                    const float o2 = O[qt][dvt][4 * g4 + 2] * inv * (gv2 / (1.0f + __expf(-gv2)));
                    const float o3 = O[qt][dvt][4 * g4 + 3] * inv * (gv3 / (1.0f + __expf(-gv3)));
                    u32x2 o; o[0] = pk2(o0, o1); o[1] = pk2(o2, o3);
                    *(u32x2*)(op + dv) = o;
                }
        }
    }
#undef ATT_GLOAD_K
#undef ATT_LSTORE_K
#undef ATT_GLOAD_V
#undef ATT_LSTORE_V
}

DI void phase_attn(const Params& P, int l, char* lds) {
    for_items(NBATCH * 160, [&](int id) {
        const int b = id / 160, w = id % 160;
        if (w < 48) { const int g = w % 3, qb = (w / 3) & 7, kvh = w / 24; attn_item<0, 2>(P, l, b, kvh * 3 + g, kvh, qb, lds); }
        else if (w < 112) { const int u = w - 48; attn_item<2, 1>(P, l, b, u & 3, 0, u >> 2, lds); }
        else { const int u = w - 112; const int g = u % 3, qb = (u / 3) & 7, kvh = u / 24; attn_item<1, 2>(P, l, b, kvh * 3 + g, kvh, qb, lds); }
    });
}

constexpr int N_PHASES = 13;
DI void run_phase(const Params& P, int ph, char* lds) {
    if (ph == 0) { phase_prep(P); phase_norm<false>(P.x, P.xb, nullptr, nullptr); return; }
    if (ph == 12) { phase_norm<true>(P.out, nullptr, P.out, P.final_g); return; }
    const int l = (ph >= 6) ? 1 : 0;
    const int sub = ph - 6 * l;
    if (sub == 0) { phase_norm<false>(P.out, P.xb, nullptr, nullptr); return; }
    if (sub == 1) {
        GemmArgs g{P.xb, 1024, P.winT + (long)l * IN_PAD * 1024, 1024, 1024};
        EpiZ epi{P.z, P.vtA, P.vtB};
        for_items(256 * 21, [&](int t) { gemm_tile(g, (t / 21) * 128, (t % 21) * 128, lds, epi); });
        return;
    }
    if (sub == 2) { phase_kprep(P, l); return; }
    if (sub == 3) {
        GemmArgs gq{P.z + OFF_CQ, IN_COLS, P.wuqT + (long)l * 384 * 192, 192, 192};
        GemmArgs gk{P.z + OFF_CKV, IN_COLS, P.wukvT + (long)l * 512 * 128, 128, 128};
        EpiQC eq{P.qc};
        EpiKV ek{P.kc, P.vtC};
        for_items(256 * 8, [&](int t) {
            const int mt = t >> 3, n = t & 7;
            if (n < 3) gemm_tile(gq, mt * 128, n * 128, lds, eq);
            else if (n < 7) gemm_tile(gk, mt * 128, (n - 3) * 128, lds, ek);
        });
        return;
    }
    if (sub == 4) { phase_attn(P, l, lds); return; }
    if (sub == 5) {
        GemmArgs g{P.xb, 1024, P.woutT + (long)l * 1024 * 1024, 1024, 1024};
        EpiOut epi{(l == 0) ? P.x : P.out, P.out};
        for_items(256 * 8, [&](int t) { gemm_tile(g, (t >> 3) * 128, (t & 7) * 128, lds, epi); });
        return;
    }
}

template <bool COOP>
__global__ void __launch_bounds__(256, 2) mega(Params P, int plo, int phi) {
    __shared__ __attribute__((aligned(16))) char lds[65536];
    for (int ph = plo; ph < phi; ++ph) {
        run_phase(P, ph, lds);
        if (COOP) { if (ph + 1 < phi) cg::this_grid().sync(); }
    }
}

extern "C" void kernel_launch(void* const* d_in, const int* in_sizes, int n_in, void* d_out, int out_size, void* d_ws, size_t ws_size, hipStream_t stream) {
    Params P{};
    P.x = (const float*)d_in[0]; P.norm_g = (const float*)d_in[1]; P.w_in = (const float*)d_in[2]; P.a_qn = (const float*)d_in[3];
    P.a_kn = (const float*)d_in[4]; P.b_sink = (const float*)d_in[5]; P.c_qn = (const float*)d_in[6]; P.c_kvn = (const float*)d_in[7];
    P.c_wuq = (const float*)d_in[8]; P.c_wukv = (const float*)d_in[9]; P.w_out = (const float*)d_in[10]; P.final_g = (const float*)d_in[11];
    P.out = (float*)d_out;
    char* w = (char*)d_ws;
    size_t off = 0;
    auto take = [&](size_t bytes) { char* p = w + off; off += (bytes + 255) & ~(size_t)255; return p; };
    P.xb = (bf16_t*)take((size_t)NTOK * 1024 * 2);
    P.z = (bf16_t*)take((size_t)NTOK * IN_COLS * 2);
    P.qc = (bf16_t*)take((size_t)NTOK * 384 * 2);
    P.kc = (bf16_t*)take((size_t)NTOK * 256 * 2);
    P.vtA = (bf16_t*)take((size_t)NBATCH * 2 * 64 * SEQ * 2);
    P.vtB = (bf16_t*)take((size_t)NBATCH * 2 * 64 * SEQ * 2);
    P.vtC = (bf16_t*)take((size_t)NBATCH * 4 * 64 * SEQ * 2);
    P.winT = (bf16_t*)take((size_t)2 * IN_PAD * 1024 * 2);
    P.woutT = (bf16_t*)take((size_t)2 * 1024 * 1024 * 2);
    P.wuqT = (bf16_t*)take((size_t)2 * 384 * 192 * 2);
    P.wukvT = (bf16_t*)take((size_t)2 * 512 * 128 * 2);
    P.t32 = (float2*)take((size_t)2048 * 48 * 8);
    if (off > ws_size) { fprintf(stderr, "workspace too small: need %zu have %zu\n", off, ws_size); return; }

    static int grid_blocks = 0;
    if (!grid_blocks) {
        int dev = 0, cus = 0, per_cu = 0;
        hipGetDevice(&dev);
        hipDeviceGetAttribute(&cus, hipDeviceAttributeMultiprocessorCount, dev);
#if MK_COOP
        hipOccupancyMaxActiveBlocksPerMultiprocessor(&per_cu, mega<true>, 256, 0);
#else
        hipOccupancyMaxActiveBlocksPerMultiprocessor(&per_cu, mega<false>, 256, 0);
#endif
        if (per_cu < 1) per_cu = 1;
        if (per_cu > 2) per_cu = 2;
        grid_blocks = cus * per_cu;
    }
#if MK_COOP
    int plo = 0, phi = N_PHASES;
    void* args[] = {&P, &plo, &phi};
    hipError_t e = hipLaunchCooperativeKernel((void*)mega<true>, dim3(grid_blocks), dim3(256), args, 0, stream);
    if (e != hipSuccess) fprintf(stderr, "cooperative launch failed: %s (grid %d)\n", hipGetErrorString(e), grid_blocks);
#else
    for (int ph = 0; ph < N_PHASES; ++ph) mega<false><<<dim3(grid_blocks), dim3(256), 0, stream>>>(P, ph, ph + 1);
#endif
}
#ifdef RES_PROBE
__global__ void __launch_bounds__(256, 2) probe_prep(Params P) { phase_prep(P); }
__global__ void __launch_bounds__(256, 2) probe_norm(Params P) { phase_norm<false>(P.x, P.xb, nullptr, nullptr); }
__global__ void __launch_bounds__(256, 2) probe_kprep(Params P) { phase_kprep(P, 1); }
__global__ void __launch_bounds__(256, 2) probe_gemmz(Params P) { __shared__ __attribute__((aligned(16))) char lds[65536]; run_phase(P, 1, lds); }
__global__ void __launch_bounds__(256, 2) probe_gemmc(Params P) { __shared__ __attribute__((aligned(16))) char lds[65536]; run_phase(P, 3, lds); }
__global__ void __launch_bounds__(256, 2) probe_gemmo(Params P) { __shared__ __attribute__((aligned(16))) char lds[65536]; run_phase(P, 5, lds); }
__global__ void __launch_bounds__(256, 2) probe_attn0(Params P, int a, int b, int c) { __shared__ __attribute__((aligned(16))) char lds[65536]; attn_item<0, 2>(P, 1, a, b, c, 3, lds); }
__global__ void __launch_bounds__(256, 2) probe_attn1(Params P, int a, int b, int c) { __shared__ __attribute__((aligned(16))) char lds[65536]; attn_item<1, 2>(P, 1, a, b, c, 3, lds); }
__global__ void __launch_bounds__(256, 2) probe_attn2(Params P, int a, int b, int c) { __shared__ __attribute__((aligned(16))) char lds[65536]; attn_item<2, 1>(P, 1, a, b, c, 3, lds); }
#endif
```

```cpp
#include <hip/hip_runtime.h>
#include <hip/hip_cooperative_groups.h>
#include <stdint.h>
#include <cstdio>
namespace cg = cooperative_groups;

#ifndef REP_MASK
#define REP_MASK 0
#endif
#ifndef MK_COOP
#define MK_COOP 1
#endif

#define DI __device__ __forceinline__
typedef unsigned short bf16_t;
typedef short bf16x8 __attribute__((ext_vector_type(8)));
typedef float f32x16 __attribute__((ext_vector_type(16)));
typedef unsigned u32x4 __attribute__((ext_vector_type(4)));
typedef unsigned u32x2 __attribute__((ext_vector_type(2)));
typedef __bf16 bf2_t __attribute__((ext_vector_type(2)));
typedef float f2_t __attribute__((ext_vector_type(2)));

constexpr int D_MODEL = 1024, SEQ = 2048, NBATCH = 16, NTOK = NBATCH * SEQ;
constexpr int IN_COLS = 2656, IN_PAD = 2688;
constexpr int OFF_AQ = 0, OFF_AK = 384, OFF_AV = 512, OFF_AG = 640, OFF_BQ = 1024, OFF_BK = 1408, OFF_BV = 1536,
              OFF_BG = 1664, OFF_CQ = 2048, OFF_CKV = 2240, OFF_CKR = 2368, OFF_CG = 2400;
constexpr int T64_OFF = 2048 * 16;
constexpr float EPS = 1e-6f;
constexpr float LOG2E = 1.4426950408889634f;

struct Params {
    const float *x, *norm_g, *w_in, *a_qn, *a_kn, *b_sink, *c_qn, *c_kvn, *c_wuq, *c_wukv, *w_out, *final_g;
    float* out;
    bf16_t *xb, *z, *qc, *kc, *vtA, *vtB, *vtC, *winT, *woutT, *wuqT, *wukvT;
    unsigned* bar;
    float2 *t32;
};

DI unsigned pk2(float lo, float hi) { f2_t v = {lo, hi}; return __builtin_bit_cast(unsigned, __builtin_convertvector(v, bf2_t)); }
DI float bflo(unsigned u) { return __uint_as_float(u << 16); }
DI float bfhi(unsigned u) { return __uint_as_float(u & 0xffff0000u); }
DI void unpack8(const u32x4& raw, float* v) {
#pragma unroll
    for (int k = 0; k < 4; ++k) { v[2 * k] = bflo(raw[k]); v[2 * k + 1] = bfhi(raw[k]); }
}
DI u32x4 pack8(const float* v) { u32x4 o; o[0] = pk2(v[0], v[1]); o[1] = pk2(v[2], v[3]); o[2] = pk2(v[4], v[5]); o[3] = pk2(v[6], v[7]); return o; }
DI float wave_sum(float v) {
#pragma unroll
    for (int o = 32; o >= 1; o >>= 1) v += __shfl_xor(v, o);
    return v;
}
DI int opaque_tid() { int t = threadIdx.x; asm volatile("" : "+v"(t)); return t; }
DI int crow(int i, int h) { return (i & 3) + 8 * (i >> 2) + 4 * h; }
#define MFMA32(a, b, c) __builtin_amdgcn_mfma_f32_32x32x16_bf16((a), (b), (c), 0, 0, 0)

template <class F> DI void for_items(int total, F f) {
    if ((gridDim.x & 7) == 0 && (total & 7) == 0) {
        const int x = blockIdx.x & 7, j = blockIdx.x >> 3, nb = gridDim.x >> 3, per = total >> 3;
        for (int t = j; t < per; t += nb) f(x * per + t);
    } else {
        for (int t = blockIdx.x; t < total; t += gridDim.x) f(t);
    }
}


#define XB_TMO      128
#define XB_XCNT(j)  (256  + 64 * (j))
#define XB_XSUB(j)  (1280 + 64 * (j))
#define XB_XGEN(j)  (2304 + 64 * (j))
#define XB_TOP      3328
#define XB_TOPGEN   3392
#define XCD_BAR_WORDS 3456
#define XB_SPIN_CAP (1u << 18)
#define LAS __attribute__((address_space(3)))
DI unsigned xb_ld(unsigned* p)              { return __hip_atomic_load(p, __ATOMIC_RELAXED, __HIP_MEMORY_SCOPE_AGENT); }
DI unsigned xb_add(unsigned* p, unsigned v) { return __hip_atomic_fetch_add(p, v, __ATOMIC_RELAXED, __HIP_MEMORY_SCOPE_AGENT); }
DI unsigned xb_xcc_id() { return (unsigned)__builtin_amdgcn_s_getreg((3 << 11) | 20) & 0xFu; }
#define XB_SPIN(cond, bar) do { unsigned _sp = 0; while (cond) { __builtin_amdgcn_s_sleep(1); \
    if ((++_sp & 255u) == 0u) { if (xb_ld(&(bar)[XB_TMO])) break; if (_sp > XB_SPIN_CAP) { atomicAdd(&(bar)[XB_TMO], 1u); break; } } } } while (0)
struct XcdBarrier { unsigned* bar; unsigned x; volatile LAS unsigned* st; };
DI XcdBarrier xcd_barrier_post(unsigned* bar, volatile LAS unsigned* st) {
    XcdBarrier b; b.bar = bar; b.x = xb_xcc_id(); b.st = st;
    if (threadIdx.x == 0) (void)xb_add(&bar[XB_XCNT(b.x)], 1u);
    return b;
}
DI void xcd_barrier_complete(unsigned* bar, unsigned x, unsigned& nloc, unsigned& nx) {
    const unsigned G = gridDim.x * gridDim.y * gridDim.z;
    unsigned sum, cnt, mine, sp = 0u;
    for (;;) {
        sum = 0u; cnt = 0u; mine = 0u;
#pragma unroll
        for (unsigned j = 0; j < 16; ++j) { const unsigned c = xb_ld(&bar[XB_XCNT(j)]); sum += c; cnt += (c > 0u) ? 1u : 0u; mine = (j == x) ? c : mine; }
        if (sum == G) break;
        __builtin_amdgcn_s_sleep(1);
        if ((++sp & 255u) == 0u) { if (xb_ld(&bar[XB_TMO])) break; if (sp > XB_SPIN_CAP) { atomicAdd(&bar[XB_TMO], 1u); break; } }
    }
    nloc = mine > 0u ? mine : 1u; nx = cnt > 0u ? cnt : 1u;
}
DI void xcd_barrier(const XcdBarrier& b) {
    asm volatile("s_waitcnt vmcnt(0)" ::: "memory");
    __syncthreads();
    if (threadIdx.x == 0) {
        unsigned* bar = b.bar;
        __builtin_amdgcn_s_waitcnt(0);
        unsigned nloc = b.st[0], nx = b.st[1];
        if (nloc == 0u) { xcd_barrier_complete(bar, b.x, nloc, nx); b.st[0] = nloc; b.st[1] = nx; }
        const unsigned old = xb_add(&bar[XB_XSUB(b.x)], 1u);
        const unsigned gen = old / nloc;
        if (old + 1u == (gen + 1u) * nloc) {
            __builtin_amdgcn_fence(__ATOMIC_RELEASE, "agent");
            asm volatile("s_waitcnt vmcnt(0)" ::: "memory");
            const unsigned og = xb_add(&bar[XB_TOP], 1u);
            const unsigned tg = og / nx;
            if (og + 1u == (tg + 1u) * nx) xb_add(&bar[XB_TOPGEN], 1u);
            else XB_SPIN(xb_ld(&bar[XB_TOPGEN]) == tg, bar);
            __builtin_amdgcn_fence(__ATOMIC_ACQUIRE, "agent");
            xb_add(&bar[XB_XGEN(b.x)], 1u);
            asm volatile("s_waitcnt vmcnt(0)" ::: "memory");
        } else {
            XB_SPIN(xb_ld(&bar[XB_XGEN(b.x)]) == gen, bar);
            __builtin_amdgcn_fence(__ATOMIC_ACQUIRE, "agent");
            asm volatile("s_waitcnt vmcnt(0)" ::: "memory");
        }
    }
    __syncthreads();
}

DI void transpose_convert(const float* __restrict__ W, const float* __restrict__ scale, bf16_t* __restrict__ Wt, int K, int N, int Npad, long gtid, long gthreads) {
    const int KC = K >> 3;
    const long total = (long)Npad * KC;
    for (long it = gtid; it < total; it += gthreads) {
        const int n = (int)(it % Npad), kc = (int)(it / Npad);
        u32x4 o = {0u, 0u, 0u, 0u};
        if (n < N) {
            float v[8];
#pragma unroll
            for (int j = 0; j < 8; ++j) { const int k = kc * 8 + j; float w = W[(long)k * N + n]; if (scale) w *= scale[k]; v[j] = w; }
            o = pack8(v);
        }
        *(u32x4*)(Wt + (long)n * K + kc * 8) = o;
    }
}

DI void phase_prep(const Params& P) {
    const long gtid = (long)blockIdx.x * blockDim.x + opaque_tid(), gth = (long)gridDim.x * blockDim.x;
    for (int l = 0; l < 2; ++l) {
        transpose_convert(P.w_in + (long)l * 1024 * IN_COLS, P.norm_g + l * 1024, P.winT + (long)l * IN_PAD * 1024, 1024, IN_COLS, IN_PAD, gtid, gth);
        transpose_convert(P.w_out + (long)l * 1024 * 1024, nullptr, P.woutT + (long)l * 1024 * 1024, 1024, 1024, 1024, gtid, gth);
        transpose_convert(P.c_wuq + (long)l * 192 * 384, P.c_qn + l * 192, P.wuqT + (long)l * 384 * 192, 192, 384, 384, gtid, gth);
        transpose_convert(P.c_wukv + (long)l * 128 * 512, P.c_kvn + l * 128, P.wukvT + (long)l * 512 * 128, 128, 512, 512, gtid, gth);
    }
    for (long it = gtid; it < 2048 * 16; it += gth) {
        const int p = (int)(it >> 4), i = (int)(it & 15);
        const float inv = powf(10000.0f, -(float)i / 16.0f);
        const float ang = (float)p * inv;
        float s, c; sincosf(ang, &s, &c);
        P.t32[it] = make_float2(c, s);
    }
    for (long it = gtid; it < 2048 * 32; it += gth) {
        const int p = (int)(it >> 5), i = (int)(it & 31);
        const float inv = powf(10000.0f, -(float)i / 32.0f);
        const float ang = (float)p * inv;
        float s, c; sincosf(ang, &s, &c);
        P.t32[T64_OFF + it] = make_float2(c, s);
    }
}

template <bool FINAL> DI void phase_norm(const float* xin, bf16_t* xb, float* outp, const float* g) {
    const int tid = opaque_tid(), lane = tid & 63;
    const int gw = blockIdx.x * 4 + (tid >> 6), nw = gridDim.x * 4;
    for (int row = gw; row < NTOK; row += nw) {
        const float4* p = (const float4*)(xin + (long)row * 1024);
        float4 v[4]; float ss = 0.f;
#pragma unroll
        for (int i = 0; i < 4; ++i) { v[i] = p[lane + 64 * i]; ss += v[i].x * v[i].x + v[i].y * v[i].y + v[i].z * v[i].z + v[i].w * v[i].w; }
        ss = wave_sum(ss);
        const float rinv = rsqrtf(ss * (1.0f / 1024.0f) + EPS);
#pragma unroll
        for (int i = 0; i < 4; ++i) {
            if (FINAL) {
                const float4 gg = ((const float4*)g)[lane + 64 * i];
                float4 o; o.x = v[i].x * rinv * gg.x; o.y = v[i].y * rinv * gg.y; o.z = v[i].z * rinv * gg.z; o.w = v[i].w * rinv * gg.w;
                ((float4*)(outp + (long)row * 1024))[lane + 64 * i] = o;
            } else {
                u32x2 o; o[0] = pk2(v[i].x * rinv, v[i].y * rinv); o[1] = pk2(v[i].z * rinv, v[i].w * rinv);
                *(u32x2*)(xb + (long)row * 1024 + (lane + 64 * i) * 4) = o;
            }
        }
    }
}

struct GemmArgs { const bf16_t* A; int lda; const bf16_t* Bt; int ldb; int K; };

template <class Epi>
DI void gemm_tile(const GemmArgs& g, int m0, int n0, char* lds, const Epi& epi) {
    const int tid = opaque_tid(), lane = tid & 63, wid = tid >> 6, wm = wid >> 1, wn = wid & 1;
    const int r = lane & 31, h = lane >> 5;
    f32x16 acc[2][2];
#pragma unroll
    for (int a = 0; a < 2; ++a)
#pragma unroll
        for (int b = 0; b < 2; ++b)
#pragma unroll
            for (int i = 0; i < 16; ++i) acc[a][b][i] = 0.f;
    const int srow = tid >> 3, sch = tid & 7;
    const bf16_t* ap = g.A + (long)(m0 + srow) * g.lda + sch * 8;
    const bf16_t* bp = g.Bt + (long)(n0 + srow) * g.ldb + sch * 8;
    const int soff = srow * 128 + ((sch ^ ((srow >> 1) & 7)) << 4);
    u32x4 ra[4], rb[4];
    const int nk = g.K >> 6;
#pragma unroll
    for (int i = 0; i < 4; ++i) { ra[i] = *(const u32x4*)(ap + (long)(32 * i) * g.lda); rb[i] = *(const u32x4*)(bp + (long)(32 * i) * g.ldb); }
#pragma unroll
    for (int i = 0; i < 4; ++i) { *(u32x4*)(lds + soff + i * 4096) = ra[i]; *(u32x4*)(lds + 16384 + soff + i * 4096) = rb[i]; }
    __syncthreads();
    int arow[2], brow[2];
#pragma unroll
    for (int i = 0; i < 2; ++i) { arow[i] = wm * 64 + i * 32 + r; brow[i] = wn * 64 + i * 32 + r; }
    for (int kt = 0; kt < nk; ++kt) {
        if (kt + 1 < nk) {
#pragma unroll
            for (int i = 0; i < 4; ++i) { ra[i] = *(const u32x4*)(ap + (long)(32 * i) * g.lda + (kt + 1) * 64); rb[i] = *(const u32x4*)(bp + (long)(32 * i) * g.ldb + (kt + 1) * 64); }
        }
        const char* la = lds + (kt & 1) * 32768;
        const char* lb = la + 16384;
#pragma unroll
        for (int s = 0; s < 4; ++s) {
            bf16x8 af[2], bfr[2];
#pragma unroll
            for (int i = 0; i < 2; ++i) {
                af[i] = *(const bf16x8*)(la + arow[i] * 128 + (((2 * s + h) ^ ((arow[i] >> 1) & 7)) << 4));
                bfr[i] = *(const bf16x8*)(lb + brow[i] * 128 + (((2 * s + h) ^ ((brow[i] >> 1) & 7)) << 4));
            }
#pragma unroll
            for (int a = 0; a < 2; ++a)
#pragma unroll
                for (int b = 0; b < 2; ++b) acc[a][b] = MFMA32(af[a], bfr[b], acc[a][b]);
        }
        if (kt + 1 < nk) {
            char* ls = lds + ((kt + 1) & 1) * 32768;
#pragma unroll
            for (int i = 0; i < 4; ++i) { *(u32x4*)(ls + soff + i * 4096) = ra[i]; *(u32x4*)(ls + 16384 + soff + i * 4096) = rb[i]; }
        }
        __syncthreads();
    }
    epi(acc, m0 + wm * 64, n0 + wn * 64, r, h);
}

DI void store_vt(bf16_t* dst  , const f32x16& a, int h) {
#pragma unroll
    for (int g4 = 0; g4 < 4; ++g4) {
        u32x2 o; o[0] = pk2(a[4 * g4], a[4 * g4 + 1]); o[1] = pk2(a[4 * g4 + 2], a[4 * g4 + 3]);
        *(u32x2*)(dst + 8 * g4 + 4 * h) = o;
    }
}

struct EpiZ {
    bf16_t *z, *vtA, *vtB;
    DI void operator()(const f32x16 (&acc)[2][2], int mw, int nw, int r, int h) const {
        const int ntile = nw >> 7;
        if (ntile == 4 || ntile == 12) {
            bf16_t* vt = (ntile == 4) ? vtA : vtB;
#pragma unroll
            for (int mi = 0; mi < 2; ++mi)
#pragma unroll
                for (int ni = 0; ni < 2; ++ni) {
                    const int c = (nw & 127) + ni * 32 + r, tok0 = mw + mi * 32, b = tok0 >> 11, t0 = tok0 & 2047;
                    store_vt(vt + ((long)((b * 2 + (c >> 6)) * 64 + (c & 63))) * SEQ + t0, acc[mi][ni], h);
                }
        } else {
#pragma unroll
            for (int mi = 0; mi < 2; ++mi)
#pragma unroll
                for (int ni = 0; ni < 2; ++ni) {
                    const int col = nw + ni * 32 + r;
                    if (col < IN_COLS) {
#pragma unroll
                        for (int i = 0; i < 16; ++i) z[(long)(mw + mi * 32 + crow(i, h)) * IN_COLS + col] = (bf16_t)(pk2(acc[mi][ni][i], 0.f) & 0xffffu);
                    }
                }
        }
    }
};
struct EpiQC {
    bf16_t* qc;
    DI void operator()(const f32x16 (&acc)[2][2], int mw, int nw, int r, int h) const {
#pragma unroll
        for (int mi = 0; mi < 2; ++mi)
#pragma unroll
            for (int ni = 0; ni < 2; ++ni) {
                const int col = nw + ni * 32 + r;
#pragma unroll
                for (int i = 0; i < 16; ++i) qc[(long)(mw + mi * 32 + crow(i, h)) * 384 + col] = (bf16_t)(pk2(acc[mi][ni][i], 0.f) & 0xffffu);
            }
    }
};
struct EpiKV {
    bf16_t *kc, *vtC;
    DI void operator()(const f32x16 (&acc)[2][2], int mw, int nw, int r, int h) const {
        const int head = nw >> 7;
        if (nw & 64) {
#pragma unroll
            for (int mi = 0; mi < 2; ++mi)
#pragma unroll
                for (int ni = 0; ni < 2; ++ni) {
                    const int c = ni * 32 + r, tok0 = mw + mi * 32, b = tok0 >> 11, t0 = tok0 & 2047;
                    store_vt(vtC + ((long)((b * 4 + head) * 64 + c)) * SEQ + t0, acc[mi][ni], h);
                }
        } else {
#pragma unroll
            for (int mi = 0; mi < 2; ++mi)
#pragma unroll
                for (int ni = 0; ni < 2; ++ni) {
                    const int col = head * 64 + ni * 32 + r;
#pragma unroll
                    for (int i = 0; i < 16; ++i) kc[(long)(mw + mi * 32 + crow(i, h)) * 256 + col] = (bf16_t)(pk2(acc[mi][ni][i], 0.f) & 0xffffu);
                }
        }
    }
};
struct EpiOut {
    const float* xin; float* out;
    DI void operator()(const f32x16 (&acc)[2][2], int mw, int nw, int r, int h) const {
#pragma unroll
        for (int mi = 0; mi < 2; ++mi)
#pragma unroll
            for (int ni = 0; ni < 2; ++ni) {
                const int col = nw + ni * 32 + r;
                float xv[16];
#pragma unroll
                for (int i = 0; i < 16; ++i) xv[i] = xin[(long)(mw + mi * 32 + crow(i, h)) * 1024 + col];
#pragma unroll
                for (int i = 0; i < 16; ++i) out[(long)(mw + mi * 32 + crow(i, h)) * 1024 + col] = xv[i] + acc[mi][ni][i];
            }
    }
};

DI void phase_kprep(const Params& P, int l) {
    const int tid = opaque_tid(), lane = tid & 63;
    const int gw = blockIdx.x * 4 + (tid >> 6), nw = gridDim.x * 4;
    for (int tok = gw; tok < NTOK; tok += nw) {
        const int t = tok & 2047;
        bf16_t* zr = P.z + (long)tok * IN_COLS;
        {
            const int grp = (lane < 16) ? 0 : (lane < 32) ? 1 : 2;
            const int c = (grp == 2) ? (lane & 3) : (lane & 7);
            bf16_t* ptr = (grp == 0) ? zr + OFF_AK + lane * 8 : (grp == 1) ? zr + OFF_BK + (lane - 16) * 8 : zr + OFF_CKR + (lane & 3) * 8;
            const u32x4 raw = *(const u32x4*)ptr;
            float v[8]; unpack8(raw, v);
            float ss = 0.f;
#pragma unroll
            for (int j = 0; j < 8; ++j) ss += v[j] * v[j];
            ss += __shfl_xor(ss, 1); ss += __shfl_xor(ss, 2); ss += __shfl_xor(ss, 4);
            if (grp == 0) {
                const float rinv = rsqrtf(ss * (1.0f / 64.0f) + EPS);
                const float* kn = P.a_kn + l * 64 + c * 8;
#pragma unroll
                for (int j = 0; j < 8; ++j) v[j] = v[j] * rinv * kn[j];
            }
            float pv[8];
#pragma unroll
            for (int j = 0; j < 8; ++j) { const float p2 = __shfl_xor(v[j], 2), p4 = __shfl_xor(v[j], 4); pv[j] = (grp == 1) ? p4 : p2; }
            int tidx; bool first;
            if (grp == 0) { const int pos = (c < 4) ? (t >> 6) : (t & 63); tidx = pos * 16 + (c & 1) * 8; first = !(c & 2); }
            else if (grp == 1) { tidx = T64_OFF + t * 32 + (c & 3) * 8; first = (c < 4); }
            else { tidx = t * 16 + (c & 1) * 8; first = !(c & 2); }
            const float2* tb = P.t32 + tidx;
            float o[8];
#pragma unroll
            for (int j = 0; j < 8; ++j) { const float2 cs = tb[j]; o[j] = v[j] * cs.x + (first ? -pv[j] : pv[j]) * cs.y; }
            if (lane < 36) *(u32x4*)ptr = pack8(o);
        }
        {
            const int hl = lane & 31;
            const bool lo = lane < 32;
            const bool valid = lo ? (hl < 24) : (hl < 16);
            bf16_t* ptr = lo ? zr + OFF_CQ + (valid ? hl : 0) * 8 : zr + OFF_CKV + (valid ? hl : 0) * 8;
            const u32x4 raw = *(const u32x4*)ptr;
            float v[8]; unpack8(raw, v);
            float ss = 0.f;
            if (valid) {
#pragma unroll
                for (int j = 0; j < 8; ++j) ss += v[j] * v[j];
            }
            ss += __shfl_xor(ss, 1); ss += __shfl_xor(ss, 2); ss += __shfl_xor(ss, 4); ss += __shfl_xor(ss, 8); ss += __shfl_xor(ss, 16);
            const float rinv = rsqrtf(ss * (lo ? (1.0f / 192.0f) : (1.0f / 128.0f)) + EPS);
#pragma unroll
            for (int j = 0; j < 8; ++j) v[j] *= rinv;
            if (valid) *(u32x4*)ptr = pack8(v);
        }
    }
}

template <int TYPE, int NQT>
DI void attn_item(const Params& P, int l, int b, int head, int kvh, int qb, char* lds) {
    constexpr int NS = (TYPE == 2) ? 6 : 4;
    const int tid = opaque_tid(), lane = tid & 63, wid = tid >> 6, r = lane & 31, h = lane >> 5;
    const int q0 = qb * (128 * NQT) + wid * (32 * NQT);
    const float sc = ((TYPE == 2) ? 0.10206207261596577f : 0.125f) * LOG2E;

    bf16x8 qf[NQT][NS];
#pragma unroll
    for (int qt = 0; qt < NQT; ++qt) {
        const int tq = q0 + qt * 32 + r;
        const long tok = (long)b * SEQ + tq;
        const bf16_t* src = (TYPE == 0) ? P.z + tok * IN_COLS + OFF_AQ + head * 64 : (TYPE == 1) ? P.z + tok * IN_COLS + OFF_BQ + head * 64 : P.qc + tok * 384 + head * 96;
        float qv[NS][8];
#pragma unroll
        for (int s = 0; s < NS; ++s) { const u32x4 raw = *(const u32x4*)(src + 16 * s + 8 * h); unpack8(raw, qv[s]); }
        if (TYPE == 0) {
            float ss = 0.f;
#pragma unroll
            for (int s = 0; s < 4; ++s)
#pragma unroll
                for (int j = 0; j < 8; ++j) ss += qv[s][j] * qv[s][j];
            ss += __shfl_xor(ss, 32);
            const float rinv = rsqrtf(ss * (1.0f / 64.0f) + EPS);
#pragma unroll
            for (int s = 0; s < 4; ++s)
#pragma unroll
                for (int j = 0; j < 8; ++j) qv[s][j] *= rinv * P.a_qn[l * 64 + 16 * s + 8 * h + j];
            const float2* tr = P.t32 + (tq >> 6) * 16 + 8 * h;
            const float2* tc = P.t32 + (tq & 63) * 16 + 8 * h;
#pragma unroll
            for (int j = 0; j < 8; ++j) {
                const float2 a = tr[j], c2 = tc[j];
                const float x0 = qv[0][j], x1 = qv[1][j], y0 = qv[2][j], y1 = qv[3][j];
                qv[0][j] = x0 * a.x - x1 * a.y; qv[1][j] = x1 * a.x + x0 * a.y;
                qv[2][j] = y0 * c2.x - y1 * c2.y; qv[3][j] = y1 * c2.x + y0 * c2.y;
            }
        } else if (TYPE == 1) {
            const float2* t0 = P.t32 + T64_OFF + tq * 32 + 8 * h;
#pragma unroll
            for (int j = 0; j < 8; ++j) {
                const float2 a = t0[j], c2 = t0[16 + j];
                const float x0 = qv[0][j], x1 = qv[2][j], y0 = qv[1][j], y1 = qv[3][j];
                qv[0][j] = x0 * a.x - x1 * a.y; qv[2][j] = x1 * a.x + x0 * a.y;
                qv[1][j] = y0 * c2.x - y1 * c2.y; qv[3][j] = y1 * c2.x + y0 * c2.y;
            }
        } else {
            const float2* t0 = P.t32 + tq * 16 + 8 * h;
#pragma unroll
            for (int j = 0; j < 8; ++j) {
                const float2 a = t0[j];
                const float x0 = qv[NS - 2][j], x1 = qv[NS - 1][j];
                qv[NS - 2][j] = x0 * a.x - x1 * a.y; qv[NS - 1][j] = x1 * a.x + x0 * a.y;
            }
        }
#pragma unroll
        for (int s = 0; s < NS; ++s) {
            float tmp[8];
#pragma unroll
            for (int j = 0; j < 8; ++j) tmp[j] = qv[s][j] * sc;
            qf[qt][s] = __builtin_bit_cast(bf16x8, pack8(tmp));
        }
    }

    const bf16_t* kbase; long kstride; const bf16_t* vbase; const bf16_t* krbase = nullptr;
    if (TYPE == 0) { kbase = P.z + (long)b * SEQ * IN_COLS + OFF_AK + kvh * 64; kstride = IN_COLS; vbase = P.vtA + (long)((b * 2 + kvh) * 64) * SEQ; }
    else if (TYPE == 1) { kbase = P.z + (long)b * SEQ * IN_COLS + OFF_BK + kvh * 64; kstride = IN_COLS; vbase = P.vtB + (long)((b * 2 + kvh) * 64) * SEQ; }
    else { kbase = P.kc + (long)b * SEQ * 256 + head * 64; kstride = 256; vbase = P.vtC + (long)((b * 4 + head) * 64) * SEQ; krbase = P.z + (long)b * SEQ * IN_COLS + OFF_CKR; }
    int kt_lo = 0, kt_hi = 32;
    if (TYPE == 1) { kt_lo = qb * (2 * NQT) - 2; if (kt_lo < 0) kt_lo = 0; kt_hi = qb * (2 * NQT) + 2 * NQT + 2; if (kt_hi > 32) kt_hi = 32; }

    const int srow = tid >> 3, sch = tid & 7;
    const int soff = srow * 128 + ((sch ^ ((srow >> 1) & 7)) << 4);
    const int krow_s = tid >> 2, kch_s = tid & 3;
    const int kroff = krow_s * 64 + ((kch_s ^ ((krow_s >> 2) & 3)) << 4);
    const bf16_t* kp = kbase + (long)srow * kstride + sch * 8;
    const bf16_t* vp = vbase + (long)srow * SEQ + sch * 8;
    const bf16_t* krp = (TYPE == 2) ? krbase + (long)krow_s * IN_COLS + kch_s * 8 : nullptr;
    u32x4 rs[2], rkr;
    constexpr int BUF = 20480;
#define ATT_GLOAD_K(kt_)                                                                                 \
    { _Pragma("unroll") for (int i = 0; i < 2; ++i) rs[i] = *(const u32x4*)(kp + (long)((kt_) * 64 + 32 * i) * kstride); }
#define ATT_LSTORE_K(buf_)                                                                               \
    { char* ls_ = lds + (buf_) * BUF; _Pragma("unroll") for (int i = 0; i < 2; ++i) *(u32x4*)(ls_ + soff + i * 4096) = rs[i]; }
#define ATT_GLOAD_V(kt_)                                                                                 \
    {                                                                                                    \
        _Pragma("unroll") for (int i = 0; i < 2; ++i) rs[i] = *(const u32x4*)(vp + (long)(32 * i) * SEQ + (kt_) * 64); \
        if (TYPE == 2) rkr = *(const u32x4*)(krp + (long)((kt_) * 64) * IN_COLS);                        \
    }
#define ATT_LSTORE_V(buf_)                                                                               \
    {                                                                                                    \
        char* ls_ = lds + (buf_) * BUF;                                                                  \
        _Pragma("unroll") for (int i = 0; i < 2; ++i) *(u32x4*)(ls_ + 8192 + soff + i * 4096) = rs[i];   \
        if (TYPE == 2) *(u32x4*)(ls_ + 16384 + kroff) = rkr;                                             \
    }

    const int pr = (r & 0x13) | ((r & 4) << 1) | ((r & 8) >> 1);
    int koff[NS];
#pragma unroll
    for (int s = 0; s < NS; ++s) {
        if (s < 4) koff[s] = pr * 128 + (((2 * s + h) ^ ((pr >> 1) & 7)) << 4);
        else koff[s] = 16384 + pr * 64 + (((2 * (s - 4) + h) ^ ((pr >> 2) & 3)) << 4);
    }
    int voff[2][2];
#pragma unroll
    for (int c = 0; c < 2; ++c)
#pragma unroll
        for (int s2 = 0; s2 < 2; ++s2) voff[c][s2] = 8192 + r * 128 + (((4 * c + 2 * s2 + h) ^ ((r >> 1) & 7)) << 4);

    f32x16 O[NQT][2];
#pragma unroll
    for (int a = 0; a < NQT; ++a)
#pragma unroll
        for (int d = 0; d < 2; ++d)
#pragma unroll
            for (int i = 0; i < 16; ++i) O[a][d][i] = 0.f;
    float m[NQT], lsum[NQT];
#pragma unroll
    for (int a = 0; a < NQT; ++a) {
        if (TYPE == 1) { m[a] = P.b_sink[l * 6 + head] * LOG2E; lsum[a] = (h == 0) ? 1.f : 0.f; }
        else { m[a] = -INFINITY; lsum[a] = 0.f; }
    }

    ATT_GLOAD_K(kt_lo);
    ATT_LSTORE_K(0);
    ATT_GLOAD_V(kt_lo);
    ATT_LSTORE_V(0);
    __syncthreads();
    for (int kt = kt_lo; kt < kt_hi; ++kt) {
        const int it = kt - kt_lo;
        const bool more = kt + 1 < kt_hi;
        const char* lb = lds + (it & 1) * BUF;
        bool active = true;
        if (TYPE == 1) active = (kt * 64 + 63 >= q0 - 128) && (kt * 64 <= q0 + 32 * NQT - 1 + 128);
#pragma unroll
        for (int c = 0; c < 2; ++c) {
            if (more) { if (c == 0) ATT_GLOAD_K(kt + 1) else ATT_GLOAD_V(kt + 1) }
            if (active) {
#pragma unroll
                for (int qt = 0; qt < NQT; ++qt) {
                    f32x16 S;
#pragma unroll
                    for (int i = 0; i < 16; ++i) S[i] = 0.f;
#pragma unroll
                    for (int s = 0; s < NS; ++s) {
                        const bf16x8 kf = *(const bf16x8*)(lb + koff[s] + c * ((s < 4) ? 4096 : 2048));
                        S = MFMA32(kf, qf[qt][s], S);
                    }
                    if (TYPE == 1) {
                        const int qpos = q0 + qt * 32 + r;
                        const int kb0 = kt * 64 + c * 32 + 8 * h;
#pragma unroll
                        for (int i = 0; i < 16; ++i) {
                            const int key = kb0 + (i & 3) + 4 * ((i >> 2) & 1) + 16 * (i >> 3);
                            const int d = qpos - key;
                            if (d > 128 || d < -128) S[i] = -1e30f;
                        }
                    }
                    float mx = S[0];
#pragma unroll
                    for (int i = 1; i < 16; ++i) mx = fmaxf(mx, S[i]);
                    mx = fmaxf(mx, __shfl_xor(mx, 32));
                    const float mnew = fmaxf(m[qt], mx);
                    const float alpha = __builtin_amdgcn_exp2f(m[qt] - mnew);
                    m[qt] = mnew;
                    float rs = 0.f;
#pragma unroll
                    for (int i = 0; i < 16; ++i) { const float p = __builtin_amdgcn_exp2f(S[i] - mnew); S[i] = p; rs += p; }
                    lsum[qt] = lsum[qt] * alpha + rs;
#pragma unroll
                    for (int d = 0; d < 2; ++d)
#pragma unroll
                        for (int i = 0; i < 16; ++i) O[qt][d][i] *= alpha;
#pragma unroll
                    for (int s2 = 0; s2 < 2; ++s2) {
                        u32x4 pp;
#pragma unroll
                        for (int k = 0; k < 4; ++k) pp[k] = pk2(S[8 * s2 + 2 * k], S[8 * s2 + 2 * k + 1]);
                        const bf16x8 pf = __builtin_bit_cast(bf16x8, pp);
#pragma unroll
                        for (int dvt = 0; dvt < 2; ++dvt) {
                            const bf16x8 vf = *(const bf16x8*)(lb + voff[c][s2] + dvt * 4096);
                            O[qt][dvt] = MFMA32(vf, pf, O[qt][dvt]);
                        }
                    }
                }
            }
            if (more) { if (c == 0) ATT_LSTORE_K((it + 1) & 1) else ATT_LSTORE_V((it + 1) & 1) }
        }
        __syncthreads();
    }

    bf16_t* og = P.xb;
    {
        const int tid2 = opaque_tid(), r2 = tid2 & 31, h2 = (tid2 >> 5) & 1;
        const int q02 = qb * (128 * NQT) + (tid2 >> 6) * (32 * NQT);
#pragma unroll
        for (int qt = 0; qt < NQT; ++qt) {
            const float lt = lsum[qt] + __shfl_xor(lsum[qt], 32);
            const float inv = 1.0f / lt;
            const long tok = (long)b * SEQ + q02 + qt * 32 + r2;
            const bf16_t* gp = P.z + tok * IN_COLS + ((TYPE == 0) ? OFF_AG : (TYPE == 1) ? OFF_BG : OFF_CG) + head * 64;
            bf16_t* op = og + tok * 1024 + ((TYPE == 0) ? 0 : (TYPE == 1) ? 384 : 768) + head * 64;
#pragma unroll
            for (int dvt = 0; dvt < 2; ++dvt)
#pragma unroll
                for (int g4 = 0; g4 < 4; ++g4) {
                    const int dv = dvt * 32 + 8 * g4 + 4 * h2;
                    const u32x2 graw = *(const u32x2*)(gp + dv);
                    const float gv0 = bflo(graw[0]), gv1 = bfhi(graw[0]), gv2 = bflo(graw[1]), gv3 = bfhi(graw[1]);
                    const float o0 = O[qt][dvt][4 * g4 + 0] * inv * (gv0 / (1.0f + __expf(-gv0)));
                    const float o1 = O[qt][dvt][4 * g4 + 1] * inv * (gv1 / (1.0f + __expf(-gv1)));
                    const float o2 = O[qt][dvt][4 * g4 + 2] * inv * (gv2 / (1.0f + __expf(-gv2)));
                    const float o3 = O[qt][dvt][4 * g4 + 3] * inv * (gv3 / (1.0f + __expf(-gv3)));
                    u32x2 o; o[0] = pk2(o0, o1); o[1] = pk2(o2, o3);
                    *(u32x2*)(op + dv) = o;
                }
        }
    }
#undef ATT_GLOAD_K
#undef ATT_LSTORE_K
#undef ATT_GLOAD_V
#undef ATT_LSTORE_V
}

DI void phase_attn(const Params& P, int l, char* lds) {
    for_items(NBATCH * 160, [&](int id) {
        const int b = id / 160, w = id % 160;
        if (w < 48) { const int g = w % 3, qb = (w / 3) & 7, kvh = w / 24; attn_item<0, 2>(P, l, b, kvh * 3 + g, kvh, qb, lds); }
        else if (w < 112) { const int u = w - 48; attn_item<2, 1>(P, l, b, u & 3, 0, u >> 2, lds); }
        else { const int u = w - 112; const int g = u % 3, qb = (u / 3) & 7, kvh = u / 24; attn_item<1, 2>(P, l, b, kvh * 3 + g, kvh, qb, lds); }
    });
}

constexpr int N_PHASES = 13;
DI void run_phase(const Params& P, int ph, char* lds) {
    if (ph == 0) { phase_prep(P); phase_norm<false>(P.x, P.xb, nullptr, nullptr); return; }
    if (ph == 12) { phase_norm<true>(P.out, nullptr, P.out, P.final_g); return; }
    const int l = (ph >= 6) ? 1 : 0;
    const int sub = ph - 6 * l;
    if (sub == 0) { phase_norm<false>(P.out, P.xb, nullptr, nullptr); return; }
    if (sub == 1) {
        GemmArgs g{P.xb, 1024, P.winT + (long)l * IN_PAD * 1024, 1024, 1024};
        EpiZ epi{P.z, P.vtA, P.vtB};
        for_items(256 * 21, [&](int t) { gemm_tile(g, (t / 21) * 128, (t % 21) * 128, lds, epi); });
        return;
    }
    if (sub == 2) { phase_kprep(P, l); return; }
    if (sub == 3) {
        GemmArgs gq{P.z + OFF_CQ, IN_COLS, P.wuqT + (long)l * 384 * 192, 192, 192};
        GemmArgs gk{P.z + OFF_CKV, IN_COLS, P.wukvT + (long)l * 512 * 128, 128, 128};
        EpiQC eq{P.qc};
        EpiKV ek{P.kc, P.vtC};
        for_items(256 * 8, [&](int t) {
            const int mt = t >> 3, n = t & 7;
            if (n < 3) gemm_tile(gq, mt * 128, n * 128, lds, eq);
            else if (n < 7) gemm_tile(gk, mt * 128, (n - 3) * 128, lds, ek);
        });
        return;
    }
    if (sub == 4) { phase_attn(P, l, lds); return; }
    if (sub == 5) {
        GemmArgs g{P.xb, 1024, P.woutT + (long)l * 1024 * 1024, 1024, 1024};
        EpiOut epi{(l == 0) ? P.x : P.out, P.out};
        for_items(256 * 8, [&](int t) { gemm_tile(g, (t >> 3) * 128, (t & 7) * 128, lds, epi); });
        return;
    }
}

template <bool COOP>
__global__ void __launch_bounds__(256, 2) mega(Params P, int plo, int phi) {
    __shared__ __attribute__((aligned(16))) char lds[65536];
    if (COOP) {
        __shared__ uint4 xb_words;
        if (threadIdx.x == 0) xb_words = make_uint4(0u, 0u, 0u, 0u);
        __syncthreads();
        XcdBarrier xb = xcd_barrier_post(P.bar, (volatile LAS unsigned*)&xb_words);
        for (int ph = plo; ph < phi; ++ph) {
            run_phase(P, ph, lds);
            if ((REP_MASK >> ph) & 1) { xcd_barrier(xb); run_phase(P, ph, lds); }
            if (ph + 1 < phi) {
                if (plo < 0) cg::this_grid().sync();
                xcd_barrier(xb);
            }
        }
    } else {
        for (int ph = plo; ph < phi; ++ph) run_phase(P, ph, lds);
    }
}

extern "C" void kernel_launch(void* const* d_in, const int* in_sizes, int n_in, void* d_out, int out_size, void* d_ws, size_t ws_size, hipStream_t stream) {
    Params P{};
    P.x = (const float*)d_in[0]; P.norm_g = (const float*)d_in[1]; P.w_in = (const float*)d_in[2]; P.a_qn = (const float*)d_in[3];
    P.a_kn = (const float*)d_in[4]; P.b_sink = (const float*)d_in[5]; P.c_qn = (const float*)d_in[6]; P.c_kvn = (const float*)d_in[7];
    P.c_wuq = (const float*)d_in[8]; P.c_wukv = (const float*)d_in[9]; P.w_out = (const float*)d_in[10]; P.final_g = (const float*)d_in[11];
    P.out = (float*)d_out;
    char* w = (char*)d_ws;
    size_t off = 0;
    auto take = [&](size_t bytes) { char* p = w + off; off += (bytes + 255) & ~(size_t)255; return p; };
    P.xb = (bf16_t*)take((size_t)NTOK * 1024 * 2);
    P.z = (bf16_t*)take((size_t)NTOK * IN_COLS * 2);
    P.qc = (bf16_t*)take((size_t)NTOK * 384 * 2);
    P.kc = (bf16_t*)take((size_t)NTOK * 256 * 2);
    P.vtA = (bf16_t*)take((size_t)NBATCH * 2 * 64 * SEQ * 2);
    P.vtB = (bf16_t*)take((size_t)NBATCH * 2 * 64 * SEQ * 2);
    P.vtC = (bf16_t*)take((size_t)NBATCH * 4 * 64 * SEQ * 2);
    P.winT = (bf16_t*)take((size_t)2 * IN_PAD * 1024 * 2);
    P.woutT = (bf16_t*)take((size_t)2 * 1024 * 1024 * 2);
    P.wuqT = (bf16_t*)take((size_t)2 * 384 * 192 * 2);
    P.wukvT = (bf16_t*)take((size_t)2 * 512 * 128 * 2);
    P.t32 = (float2*)take((size_t)2048 * 48 * 8);
    P.bar = (unsigned*)take((size_t)XCD_BAR_WORDS * 4);
    if (off > ws_size) { fprintf(stderr, "workspace too small: need %zu have %zu\n", off, ws_size); return; }

    static int grid_blocks = 0;
    if (!grid_blocks) {
        int dev = 0, cus = 0, per_cu = 0;
        hipGetDevice(&dev);
        hipDeviceGetAttribute(&cus, hipDeviceAttributeMultiprocessorCount, dev);
#if MK_COOP
        hipOccupancyMaxActiveBlocksPerMultiprocessor(&per_cu, mega<true>, 256, 0);
#else
        hipOccupancyMaxActiveBlocksPerMultiprocessor(&per_cu, mega<false>, 256, 0);
#endif
        if (per_cu < 1) per_cu = 1;
        if (per_cu > 2) per_cu = 2;
        grid_blocks = cus * per_cu;
    }
#if MK_COOP
    hipMemsetAsync(P.bar, 0, XCD_BAR_WORDS * 4, stream);
    int plo = 0, phi = N_PHASES;
    void* args[] = {&P, &plo, &phi};
    hipError_t e = hipLaunchCooperativeKernel((void*)mega<true>, dim3(grid_blocks), dim3(256), args, 0, stream);
    if (e != hipSuccess) fprintf(stderr, "cooperative launch failed: %s (grid %d)\n", hipGetErrorString(e), grid_blocks);
#else
    for (int ph = 0; ph < N_PHASES; ++ph) mega<false><<<dim3(grid_blocks), dim3(256), 0, stream>>>(P, ph, ph + 1);
#endif
}
#ifdef RES_PROBE
__global__ void __launch_bounds__(256, 2) probe_prep(Params P) { phase_prep(P); }
__global__ void __launch_bounds__(256, 2) probe_norm(Params P) { phase_norm<false>(P.x, P.xb, nullptr, nullptr); }
__global__ void __launch_bounds__(256, 2) probe_kprep(Params P) { phase_kprep(P, 1); }
__global__ void __launch_bounds__(256, 2) probe_gemmz(Params P) { __shared__ __attribute__((aligned(16))) char lds[65536]; run_phase(P, 1, lds); }
__global__ void __launch_bounds__(256, 2) probe_gemmc(Params P) { __shared__ __attribute__((aligned(16))) char lds[65536]; run_phase(P, 3, lds); }
__global__ void __launch_bounds__(256, 2) probe_gemmo(Params P) { __shared__ __attribute__((aligned(16))) char lds[65536]; run_phase(P, 5, lds); }
__global__ void __launch_bounds__(256, 2) probe_attn0(Params P, int a, int b, int c) { __shared__ __attribute__((aligned(16))) char lds[65536]; attn_item<0, 2>(P, 1, a, b, c, 3, lds); }
__global__ void __launch_bounds__(256, 2) probe_attn1(Params P, int a, int b, int c) { __shared__ __attribute__((aligned(16))) char lds[65536]; attn_item<1, 2>(P, 1, a, b, c, 3, lds); }
__global__ void __launch_bounds__(256, 2) probe_attn2(Params P, int a, int b, int c) { __shared__ __attribute__((aligned(16))) char lds[65536]; attn_item<2, 1>(P, 1, a, b, c, 3, lds); }
#endif
```

```cpp
#include <hip/hip_runtime.h>
#include <hip/hip_cooperative_groups.h>
#include <stdint.h>
#include <cstdio>
namespace cg = cooperative_groups;

#ifndef REP_MASK
#define REP_MASK 0
#endif
#ifndef MK_COOP
#define MK_COOP 1
#endif

#define DI __device__ __forceinline__
typedef unsigned short bf16_t;
typedef short bf16x8 __attribute__((ext_vector_type(8)));
typedef float f32x16 __attribute__((ext_vector_type(16)));
typedef unsigned u32x4 __attribute__((ext_vector_type(4)));
typedef unsigned u32x2 __attribute__((ext_vector_type(2)));
typedef __bf16 bf2_t __attribute__((ext_vector_type(2)));
typedef float f2_t __attribute__((ext_vector_type(2)));

constexpr int D_MODEL = 1024, SEQ = 2048, NBATCH = 16, NTOK = NBATCH * SEQ;
constexpr int IN_COLS = 2656, IN_PAD = 2688;
constexpr int OFF_AQ = 0, OFF_AK = 384, OFF_AV = 512, OFF_AG = 640, OFF_BQ = 1024, OFF_BK = 1408, OFF_BV = 1536,
              OFF_BG = 1664, OFF_CQ = 2048, OFF_CKV = 2240, OFF_CKR = 2368, OFF_CG = 2400;
constexpr int T64_OFF = 2048 * 16;
constexpr float EPS = 1e-6f;
constexpr float LOG2E = 1.4426950408889634f;

struct Params {
    const float *x, *norm_g, *w_in, *a_qn, *a_kn, *b_sink, *c_qn, *c_kvn, *c_wuq, *c_wukv, *w_out, *final_g;
    float* out;
    bf16_t *xb, *z, *qc, *kc, *vtA, *vtB, *vtC, *winT, *woutT, *wuqT, *wukvT;
    unsigned* bar;
    float2 *t32;
};

DI unsigned pk2(float lo, float hi) { f2_t v = {lo, hi}; return __builtin_bit_cast(unsigned, __builtin_convertvector(v, bf2_t)); }
DI float bflo(unsigned u) { return __uint_as_float(u << 16); }
DI float bfhi(unsigned u) { return __uint_as_float(u & 0xffff0000u); }
DI void unpack8(const u32x4& raw, float* v) {
#pragma unroll
    for (int k = 0; k < 4; ++k) { v[2 * k] = bflo(raw[k]); v[2 * k + 1] = bfhi(raw[k]); }
}
DI u32x4 pack8(const float* v) { u32x4 o; o[0] = pk2(v[0], v[1]); o[1] = pk2(v[2], v[3]); o[2] = pk2(v[4], v[5]); o[3] = pk2(v[6], v[7]); return o; }
DI float wave_sum(float v) {
#pragma unroll
    for (int o = 32; o >= 1; o >>= 1) v += __shfl_xor(v, o);
    return v;
}

DI float xhalf_max(float x) { const auto p = __builtin_amdgcn_permlane32_swap(__float_as_uint(x), __float_as_uint(x), false, false); return fmaxf(__uint_as_float(p[0]), __uint_as_float(p[1])); }
DI float xhalf_sum(float x) { const auto p = __builtin_amdgcn_permlane32_swap(__float_as_uint(x), __float_as_uint(x), false, false); return __uint_as_float(p[0]) + __uint_as_float(p[1]); }
DI int opaque_tid() { int t = threadIdx.x; asm volatile("" : "+v"(t)); return t; }
DI int crow(int i, int h) { return (i & 3) + 8 * (i >> 2) + 4 * h; }

typedef __attribute__((address_space(3))) unsigned lds_u32;
template <int ROWS> DI void glds_rows128(const bf16_t* src, long row_stride, char* img, int tid) {
    const int lane = tid & 63, wid = tid >> 6;
#pragma unroll
    for (int k = 0; k < ROWS / 32; ++k) {
        const int p = wid + 4 * k;
        const int row = p * 8 + (lane >> 3), pc = lane & 7, lc = pc ^ ((row >> 1) & 7);
        __builtin_amdgcn_global_load_lds((const unsigned*)(src + (long)row * row_stride + lc * 8), (lds_u32*)(img + p * 1024 + lane * 16), 16, 0, 0);
    }
}
DI void glds_rows64(const bf16_t* src, long row_stride, char* img, int tid) {
    const int lane = tid & 63, wid = tid >> 6;
    const int row = wid * 16 + (lane >> 2), pc = lane & 3, lc = pc ^ ((row >> 2) & 3);
    __builtin_amdgcn_global_load_lds((const unsigned*)(src + (long)row * row_stride + lc * 8), (lds_u32*)(img + wid * 1024 + lane * 16), 16, 0, 0);
}
#define MFMA32(a, b, c) __builtin_amdgcn_mfma_f32_32x32x16_bf16((a), (b), (c), 0, 0, 0)

template <class F> DI void for_items(int total, F f) {
    if ((gridDim.x & 7) == 0 && (total & 7) == 0) {
        const int x = blockIdx.x & 7, j = blockIdx.x >> 3, nb = gridDim.x >> 3, per = total >> 3;
        for (int t = j; t < per; t += nb) f(x * per + t);
    } else {
        for (int t = blockIdx.x; t < total; t += gridDim.x) f(t);
    }
}


#define XB_TMO      128
#define XB_XCNT(j)  (256  + 64 * (j))
#define XB_XSUB(j)  (1280 + 64 * (j))
#define XB_XGEN(j)  (2304 + 64 * (j))
#define XB_TOP      3328
#define XB_TOPGEN   3392
#define XCD_BAR_WORDS 3456
#define XB_SPIN_CAP (1u << 18)
#define LAS __attribute__((address_space(3)))
DI unsigned xb_ld(unsigned* p)              { return __hip_atomic_load(p, __ATOMIC_RELAXED, __HIP_MEMORY_SCOPE_AGENT); }
DI unsigned xb_add(unsigned* p, unsigned v) { return __hip_atomic_fetch_add(p, v, __ATOMIC_RELAXED, __HIP_MEMORY_SCOPE_AGENT); }
DI unsigned xb_xcc_id() { return (unsigned)__builtin_amdgcn_s_getreg((3 << 11) | 20) & 0xFu; }
#define XB_SPIN(cond, bar) do { unsigned _sp = 0; while (cond) { __builtin_amdgcn_s_sleep(1); \
    if ((++_sp & 255u) == 0u) { if (xb_ld(&(bar)[XB_TMO])) break; if (_sp > XB_SPIN_CAP) { atomicAdd(&(bar)[XB_TMO], 1u); break; } } } } while (0)
struct XcdBarrier { unsigned* bar; unsigned x; volatile LAS unsigned* st; };
DI XcdBarrier xcd_barrier_post(unsigned* bar, volatile LAS unsigned* st) {
    XcdBarrier b; b.bar = bar; b.x = xb_xcc_id(); b.st = st;
    if (threadIdx.x == 0) (void)xb_add(&bar[XB_XCNT(b.x)], 1u);
    return b;
}
DI void xcd_barrier_complete(unsigned* bar, unsigned x, unsigned& nloc, unsigned& nx) {
    const unsigned G = gridDim.x * gridDim.y * gridDim.z;
    unsigned sum, cnt, mine, sp = 0u;
    for (;;) {
        sum = 0u; cnt = 0u; mine = 0u;
#pragma unroll
        for (unsigned j = 0; j < 16; ++j) { const unsigned c = xb_ld(&bar[XB_XCNT(j)]); sum += c; cnt += (c > 0u) ? 1u : 0u; mine = (j == x) ? c : mine; }
        if (sum == G) break;
        __builtin_amdgcn_s_sleep(1);
        if ((++sp & 255u) == 0u) { if (xb_ld(&bar[XB_TMO])) break; if (sp > XB_SPIN_CAP) { atomicAdd(&bar[XB_TMO], 1u); break; } }
    }
    nloc = mine > 0u ? mine : 1u; nx = cnt > 0u ? cnt : 1u;
}
DI void xcd_barrier(const XcdBarrier& b) {
    asm volatile("s_waitcnt vmcnt(0)" ::: "memory");
    __syncthreads();
    if (threadIdx.x == 0) {
        unsigned* bar = b.bar;
        __builtin_amdgcn_s_waitcnt(0);
        unsigned nloc = b.st[0], nx = b.st[1];
        if (nloc == 0u) { xcd_barrier_complete(bar, b.x, nloc, nx); b.st[0] = nloc; b.st[1] = nx; }
        const unsigned old = xb_add(&bar[XB_XSUB(b.x)], 1u);
        const unsigned gen = old / nloc;
        if (old + 1u == (gen + 1u) * nloc) {
            __builtin_amdgcn_fence(__ATOMIC_RELEASE, "agent");
            asm volatile("s_waitcnt vmcnt(0)" ::: "memory");
            const unsigned og = xb_add(&bar[XB_TOP], 1u);
            const unsigned tg = og / nx;
            if (og + 1u == (tg + 1u) * nx) xb_add(&bar[XB_TOPGEN], 1u);
            else XB_SPIN(xb_ld(&bar[XB_TOPGEN]) == tg, bar);
            __builtin_amdgcn_fence(__ATOMIC_ACQUIRE, "agent");
            xb_add(&bar[XB_XGEN(b.x)], 1u);
            asm volatile("s_waitcnt vmcnt(0)" ::: "memory");
        } else {
            XB_SPIN(xb_ld(&bar[XB_XGEN(b.x)]) == gen, bar);
            __builtin_amdgcn_fence(__ATOMIC_ACQUIRE, "agent");
            asm volatile("s_waitcnt vmcnt(0)" ::: "memory");
        }
    }
    __syncthreads();
}

DI void transpose_convert(const float* __restrict__ W, const float* __restrict__ scale, bf16_t* __restrict__ Wt, int K, int N, int Npad, long gtid, long gthreads) {
    const int KC = K >> 3;
    const long total = (long)Npad * KC;
    for (long it = gtid; it < total; it += gthreads) {
        const int n = (int)(it % Npad), kc = (int)(it / Npad);
        u32x4 o = {0u, 0u, 0u, 0u};
        if (n < N) {
            float v[8];
#pragma unroll
            for (int j = 0; j < 8; ++j) { const int k = kc * 8 + j; float w = W[(long)k * N + n]; if (scale) w *= scale[k]; v[j] = w; }
            o = pack8(v);
        }
        *(u32x4*)(Wt + (long)n * K + kc * 8) = o;
    }
}

DI void phase_prep(const Params& P) {
    const long gtid = (long)blockIdx.x * blockDim.x + opaque_tid(), gth = (long)gridDim.x * blockDim.x;
    for (int l = 0; l < 2; ++l) {
        transpose_convert(P.w_in + (long)l * 1024 * IN_COLS, P.norm_g + l * 1024, P.winT + (long)l * IN_PAD * 1024, 1024, IN_COLS, IN_PAD, gtid, gth);
        transpose_convert(P.w_out + (long)l * 1024 * 1024, nullptr, P.woutT + (long)l * 1024 * 1024, 1024, 1024, 1024, gtid, gth);
        transpose_convert(P.c_wuq + (long)l * 192 * 384, P.c_qn + l * 192, P.wuqT + (long)l * 384 * 192, 192, 384, 384, gtid, gth);
        transpose_convert(P.c_wukv + (long)l * 128 * 512, P.c_kvn + l * 128, P.wukvT + (long)l * 512 * 128, 128, 512, 512, gtid, gth);
    }
    for (long it = gtid; it < 2048 * 16; it += gth) {
        const int p = (int)(it >> 4), i = (int)(it & 15);
        const float inv = powf(10000.0f, -(float)i / 16.0f);
        const float ang = (float)p * inv;
        float s, c; sincosf(ang, &s, &c);
        P.t32[it] = make_float2(c, s);
    }
    for (long it = gtid; it < 2048 * 32; it += gth) {
        const int p = (int)(it >> 5), i = (int)(it & 31);
        const float inv = powf(10000.0f, -(float)i / 32.0f);
        const float ang = (float)p * inv;
        float s, c; sincosf(ang, &s, &c);
        P.t32[T64_OFF + it] = make_float2(c, s);
    }
}

template <bool FINAL> DI void phase_norm(const float* xin, bf16_t* xb, float* outp, const float* g) {
    const int tid = opaque_tid(), lane = tid & 63;
    const int gw = blockIdx.x * 4 + (tid >> 6), nw = gridDim.x * 4;
    constexpr int RW = 2;
    for (int row0 = gw * RW; row0 < NTOK; row0 += nw * RW) {
        float4 v[RW][4];
#pragma unroll
        for (int u = 0; u < RW; ++u) {
            const float4* p = (const float4*)(xin + (long)(row0 + u) * 1024);
#pragma unroll
            for (int i = 0; i < 4; ++i) v[u][i] = p[lane + 64 * i];
        }
        float4 gg[4];
        if (FINAL) {
#pragma unroll
            for (int i = 0; i < 4; ++i) gg[i] = ((const float4*)g)[lane + 64 * i];
        }
#pragma unroll
        for (int u = 0; u < RW; ++u) {
            float ss = 0.f;
#pragma unroll
            for (int i = 0; i < 4; ++i) ss += v[u][i].x * v[u][i].x + v[u][i].y * v[u][i].y + v[u][i].z * v[u][i].z + v[u][i].w * v[u][i].w;
            ss = wave_sum(ss);
            const float rinv = rsqrtf(ss * (1.0f / 1024.0f) + EPS);
            const long row = row0 + u;
#pragma unroll
            for (int i = 0; i < 4; ++i) {
                if (FINAL) {
                    float4 o; o.x = v[u][i].x * rinv * gg[i].x; o.y = v[u][i].y * rinv * gg[i].y; o.z = v[u][i].z * rinv * gg[i].z; o.w = v[u][i].w * rinv * gg[i].w;
                    ((float4*)(outp + row * 1024))[lane + 64 * i] = o;
                } else {
                    u32x2 o; o[0] = pk2(v[u][i].x * rinv, v[u][i].y * rinv); o[1] = pk2(v[u][i].z * rinv, v[u][i].w * rinv);
                    *(u32x2*)(xb + row * 1024 + (lane + 64 * i) * 4) = o;
                }
            }
        }
    }
}

struct GemmArgs { const bf16_t* A; int lda; const bf16_t* Bt; int ldb; int K; };

template <class Epi>
DI void gemm_tile(const GemmArgs& g, int m0, int n0, char* lds, const Epi& epi) {
    const int tid = opaque_tid(), lane = tid & 63, wid = tid >> 6, wm = wid >> 1, wn = wid & 1;
    const int r = lane & 31, h = lane >> 5;
    f32x16 acc[2][2];
#pragma unroll
    for (int a = 0; a < 2; ++a)
#pragma unroll
        for (int b = 0; b < 2; ++b)
#pragma unroll
            for (int i = 0; i < 16; ++i) acc[a][b][i] = 0.f;
    const bf16_t* ap = g.A + (long)m0 * g.lda;
    const bf16_t* bp = g.Bt + (long)n0 * g.ldb;
    const int nk = g.K >> 6;
    glds_rows128<128>(ap, g.lda, lds, tid);
    glds_rows128<128>(bp, g.ldb, lds + 16384, tid);
    __syncthreads();
    int arow[2], brow[2];
#pragma unroll
    for (int i = 0; i < 2; ++i) { arow[i] = wm * 64 + i * 32 + r; brow[i] = wn * 64 + i * 32 + r; }
    for (int kt = 0; kt < nk; ++kt) {
        if (kt + 1 < nk) {
            char* ls = lds + ((kt + 1) & 1) * 32768;
            glds_rows128<128>(ap + (kt + 1) * 64, g.lda, ls, tid);
            glds_rows128<128>(bp + (kt + 1) * 64, g.ldb, ls + 16384, tid);
        }
        const char* la = lds + (kt & 1) * 32768;
        const char* lb = la + 16384;
#pragma unroll
        for (int s = 0; s < 4; ++s) {
            bf16x8 af[2], bfr[2];
#pragma unroll
            for (int i = 0; i < 2; ++i) {
                af[i] = *(const bf16x8*)(la + arow[i] * 128 + (((2 * s + h) ^ ((arow[i] >> 1) & 7)) << 4));
                bfr[i] = *(const bf16x8*)(lb + brow[i] * 128 + (((2 * s + h) ^ ((brow[i] >> 1) & 7)) << 4));
            }
#pragma unroll
            for (int a = 0; a < 2; ++a)
#pragma unroll
                for (int b = 0; b < 2; ++b) acc[a][b] = MFMA32(bfr[b], af[a], acc[a][b]);
        }
        __syncthreads();
    }
    epi(acc, lds, m0, n0, tid);
    __syncthreads();
}

DI int img16(int row, int col) { return row * 256 + ((((col >> 3) ^ (row & 15))) << 4) + (col & 7) * 2; }
DI void epi_stage_bf16(const f32x16 (&acc)[2][2], char* img, int tid) {
    const int lane = tid & 63, wid = tid >> 6, wm = wid >> 1, wn = wid & 1, r = lane & 31, h = lane >> 5;
#pragma unroll
    for (int a = 0; a < 2; ++a)
#pragma unroll
        for (int b = 0; b < 2; ++b) {
            const int row = wm * 64 + a * 32 + r;
#pragma unroll
            for (int g4 = 0; g4 < 4; ++g4) {
                const int col = wn * 64 + b * 32 + 8 * g4 + 4 * h;
                u32x2 v; v[0] = pk2(acc[a][b][4 * g4], acc[a][b][4 * g4 + 1]); v[1] = pk2(acc[a][b][4 * g4 + 2], acc[a][b][4 * g4 + 3]);
                *(u32x2*)(img + img16(row, col)) = v;
            }
        }
}
DI void epi_stage_vt(const f32x16 (&acc)[2][2], char* img, int tid, int ncol0) {
    const int lane = tid & 63, wid = tid >> 6, wm = wid >> 1, wn = wid & 1, r = lane & 31, h = lane >> 5;
#pragma unroll
    for (int a = 0; a < 2; ++a)
#pragma unroll
        for (int b = 0; b < 2; ++b) {
            const int m = wm * 64 + a * 32 + r;
#pragma unroll
            for (int i = 0; i < 16; ++i) {
                const int n = wn * 64 + b * 32 + crow(i, h) - ncol0;
                *(bf16_t*)(img + img16(n, m)) = (bf16_t)(pk2(acc[a][b][i], 0.f) & 0xffffu);
            }
        }
}
template <int NROWS, int NCH> DI void epi_copy16(const char* img, bf16_t* dst0, long dstride, int tid, int ch_limit) {
    constexpr int LOG = (NCH == 16) ? 4 : 3;
#pragma unroll
    for (int k = 0; k < NROWS * NCH / 256; ++k) {
        const int idx = tid + 256 * k, row = idx >> LOG, ch = idx & (NCH - 1);
        const u32x4 v = *(const u32x4*)(img + row * 256 + ((ch ^ (row & 15)) << 4));
        if (ch < ch_limit) *(u32x4*)(dst0 + (long)row * dstride + ch * 8) = v;
    }
}

struct EpiZ {
    bf16_t *z, *vtA, *vtB;
    DI void operator()(const f32x16 (&acc)[2][2], char* lds, int m0, int n0, int tid) const {
        const int ntile = n0 >> 7;
        if (ntile == 4 || ntile == 12) {
            epi_stage_vt(acc, lds, tid, 0);
            __syncthreads();
            bf16_t* vt = (ntile == 4) ? vtA : vtB;
            const int b = m0 >> 11, t0 = m0 & 2047;
            epi_copy16<128, 16>(lds, vt + (long)(b * 2 * 64) * SEQ + t0, SEQ, tid, 16);
        } else {
            epi_stage_bf16(acc, lds, tid);
            __syncthreads();
            epi_copy16<128, 16>(lds, z + (long)m0 * IN_COLS + n0, IN_COLS, tid, (IN_COLS - n0) >> 3);
        }
    }
};
struct EpiQC {
    bf16_t* qc;
    DI void operator()(const f32x16 (&acc)[2][2], char* lds, int m0, int n0, int tid) const {
        epi_stage_bf16(acc, lds, tid);
        __syncthreads();
        epi_copy16<128, 16>(lds, qc + (long)m0 * 384 + n0, 384, tid, 16);
    }
};
struct EpiKV {
    bf16_t *kc, *vtC;
    DI void operator()(const f32x16 (&acc)[2][2], char* lds, int m0, int n0, int tid) const {
        const int head = n0 >> 7, wn = (tid >> 6) & 1;
        if (wn == 0) epi_stage_bf16(acc, lds, tid);
        else epi_stage_vt(acc, lds + 32768, tid, 64);
        __syncthreads();
        epi_copy16<128, 8>(lds, kc + (long)m0 * 256 + head * 64, 256, tid, 8);
        const int b = m0 >> 11, t0 = m0 & 2047;
        epi_copy16<64, 16>(lds + 32768, vtC + (long)((b * 4 + head) * 64) * SEQ + t0, SEQ, tid, 16);
    }
};
struct EpiOut {
    const float* xin; float* out;
    DI void operator()(const f32x16 (&acc)[2][2], char* lds, int m0, int n0, int tid) const {
        const int lane = tid & 63, wid = tid >> 6, wm = wid >> 1, wn = wid & 1, r = lane & 31, h = lane >> 5;
#pragma unroll
        for (int a = 0; a < 2; ++a)
#pragma unroll
            for (int b = 0; b < 2; ++b) {
                const int row = wm * 64 + a * 32 + r;
#pragma unroll
                for (int g4 = 0; g4 < 4; ++g4) {
                    const int ch = (wn * 64 + b * 32 + 8 * g4 + 4 * h) >> 2;
                    float4 v; v.x = acc[a][b][4 * g4]; v.y = acc[a][b][4 * g4 + 1]; v.z = acc[a][b][4 * g4 + 2]; v.w = acc[a][b][4 * g4 + 3];
                    *(float4*)(lds + row * 512 + ((ch ^ (row & 7)) << 4)) = v;
                }
            }
        __syncthreads();
#pragma unroll
        for (int k2 = 0; k2 < 2; ++k2) {
            float4 xv[8];
#pragma unroll
            for (int k = 0; k < 8; ++k) { const int idx = tid + 256 * (k2 * 8 + k), row = idx >> 5, ch = idx & 31; xv[k] = *(const float4*)(xin + (long)(m0 + row) * 1024 + n0 + ch * 4); }
#pragma unroll
            for (int k = 0; k < 8; ++k) {
                const int idx = tid + 256 * (k2 * 8 + k), row = idx >> 5, ch = idx & 31;
                const float4 v = *(const float4*)(lds + row * 512 + ((ch ^ (row & 7)) << 4));
                float4 o; o.x = xv[k].x + v.x; o.y = xv[k].y + v.y; o.z = xv[k].z + v.z; o.w = xv[k].w + v.w;
                *(float4*)(out + (long)(m0 + row) * 1024 + n0 + ch * 4) = o;
            }
        }
    }
};

DI void phase_kprep(const Params& P, int l) {
    const int tid = opaque_tid(), lane = tid & 63;
    const int gw = blockIdx.x * 4 + (tid >> 6), nw = gridDim.x * 4;
    constexpr int TK = 4;
    const int grp = (lane < 16) ? 0 : (lane < 32) ? 1 : 2;
    const int c = (grp == 2) ? (lane & 3) : (lane & 7);
    const int off1 = (grp == 0) ? OFF_AK + lane * 8 : (grp == 1) ? OFF_BK + (lane - 16) * 8 : OFF_CKR + (lane & 3) * 8;
    const int hl = lane & 31;
    const bool lo = lane < 32;
    const bool valid2 = lo ? (hl < 24) : (hl < 16);
    const int off2 = (lo ? OFF_CQ : OFF_CKV) + (valid2 ? hl : 0) * 8;
    const bool first = (grp == 1) ? (c < 4) : !(c & 2);
    float kn[8];
#pragma unroll
    for (int j = 0; j < 8; ++j) kn[j] = (grp == 0) ? P.a_kn[l * 64 + c * 8 + j] : 1.0f;
    for (int tok0 = gw * TK; tok0 < NTOK; tok0 += nw * TK) {
        u32x4 raw1[TK], raw2[TK];
        float2 cs[TK][8];
#pragma unroll
        for (int u = 0; u < TK; ++u) {
            const int tok = tok0 + u, t = tok & 2047;
            const bf16_t* zr = P.z + (long)tok * IN_COLS;
            raw1[u] = *(const u32x4*)(zr + off1);
            raw2[u] = *(const u32x4*)(zr + off2);
            int tidx;
            if (grp == 0) { const int pos = (c < 4) ? (t >> 6) : (t & 63); tidx = pos * 16 + (c & 1) * 8; }
            else if (grp == 1) tidx = T64_OFF + t * 32 + (c & 3) * 8;
            else tidx = t * 16 + (c & 1) * 8;
            const float2* tb = P.t32 + tidx;
#pragma unroll
            for (int j = 0; j < 8; ++j) cs[u][j] = tb[j];
        }
#pragma unroll
        for (int u = 0; u < TK; ++u) {
            bf16_t* zr = P.z + (long)(tok0 + u) * IN_COLS;
            {
                float v[8]; unpack8(raw1[u], v);
                float ss = 0.f;
#pragma unroll
                for (int j = 0; j < 8; ++j) ss += v[j] * v[j];
                ss += __shfl_xor(ss, 1); ss += __shfl_xor(ss, 2); ss += __shfl_xor(ss, 4);
                if (grp == 0) {
                    const float rinv = rsqrtf(ss * (1.0f / 64.0f) + EPS);
#pragma unroll
                    for (int j = 0; j < 8; ++j) v[j] = v[j] * rinv * kn[j];
                }
                float o[8];
#pragma unroll
                for (int j = 0; j < 8; ++j) {
                    const float p2 = __shfl_xor(v[j], 2), p4 = __shfl_xor(v[j], 4);
                    const float pv = (grp == 1) ? p4 : p2;
                    o[j] = v[j] * cs[u][j].x + (first ? -pv : pv) * cs[u][j].y;
                }
                if (lane < 36) *(u32x4*)(zr + off1) = pack8(o);
            }
            {
                float v[8]; unpack8(raw2[u], v);
                float ss = 0.f;
                if (valid2) {
#pragma unroll
                    for (int j = 0; j < 8; ++j) ss += v[j] * v[j];
                }
                ss += __shfl_xor(ss, 1); ss += __shfl_xor(ss, 2); ss += __shfl_xor(ss, 4); ss += __shfl_xor(ss, 8); ss += __shfl_xor(ss, 16);
                const float rinv = rsqrtf(ss * (lo ? (1.0f / 192.0f) : (1.0f / 128.0f)) + EPS);
#pragma unroll
                for (int j = 0; j < 8; ++j) v[j] *= rinv;
                if (valid2) *(u32x4*)(zr + off2) = pack8(v);
            }
        }
    }
}

template <int TYPE, int NQT>
DI void attn_item(const Params& P, int l, int b, int head, int kvh, int qb, char* lds) {
    constexpr int NS = (TYPE == 2) ? 6 : 4;
    const int tid = opaque_tid(), lane = tid & 63, wid = __builtin_amdgcn_readfirstlane(tid >> 6), r = lane & 31, h = lane >> 5;
    const int q0 = qb * (128 * NQT) + wid * (32 * NQT);
    const float sc = ((TYPE == 2) ? 0.10206207261596577f : 0.125f) * LOG2E;

    bf16x8 qf[NQT][NS];
#pragma unroll
    for (int qt = 0; qt < NQT; ++qt) {
        const int tq = q0 + qt * 32 + r;
        const long tok = (long)b * SEQ + tq;
        const bf16_t* src = (TYPE == 0) ? P.z + tok * IN_COLS + OFF_AQ + head * 64 : (TYPE == 1) ? P.z + tok * IN_COLS + OFF_BQ + head * 64 : P.qc + tok * 384 + head * 96;
        float qv[NS][8];
#pragma unroll
        for (int s = 0; s < NS; ++s) { const u32x4 raw = *(const u32x4*)(src + 16 * s + 8 * h); unpack8(raw, qv[s]); }
        if (TYPE == 0) {
            float ss = 0.f;
#pragma unroll
            for (int s = 0; s < 4; ++s)
#pragma unroll
                for (int j = 0; j < 8; ++j) ss += qv[s][j] * qv[s][j];
            ss = xhalf_sum(ss);
            const float rinv = rsqrtf(ss * (1.0f / 64.0f) + EPS);
#pragma unroll
            for (int s = 0; s < 4; ++s)
#pragma unroll
                for (int j = 0; j < 8; ++j) qv[s][j] *= rinv * P.a_qn[l * 64 + 16 * s + 8 * h + j];
            const float2* tr = P.t32 + (tq >> 6) * 16 + 8 * h;
            const float2* tc = P.t32 + (tq & 63) * 16 + 8 * h;
#pragma unroll
            for (int j = 0; j < 8; ++j) {
                const float2 a = tr[j], c2 = tc[j];
                const float x0 = qv[0][j], x1 = qv[1][j], y0 = qv[2][j], y1 = qv[3][j];
                qv[0][j] = x0 * a.x - x1 * a.y; qv[1][j] = x1 * a.x + x0 * a.y;
                qv[2][j] = y0 * c2.x - y1 * c2.y; qv[3][j] = y1 * c2.x + y0 * c2.y;
            }
        } else if (TYPE == 1) {
            const float2* t0 = P.t32 + T64_OFF + tq * 32 + 8 * h;
#pragma unroll
            for (int j = 0; j < 8; ++j) {
                const float2 a = t0[j], c2 = t0[16 + j];
                const float x0 = qv[0][j], x1 = qv[2][j], y0 = qv[1][j], y1 = qv[3][j];
                qv[0][j] = x0 * a.x - x1 * a.y; qv[2][j] = x1 * a.x + x0 * a.y;
                qv[1][j] = y0 * c2.x - y1 * c2.y; qv[3][j] = y1 * c2.x + y0 * c2.y;
            }
        } else {
            const float2* t0 = P.t32 + tq * 16 + 8 * h;
#pragma unroll
            for (int j = 0; j < 8; ++j) {
                const float2 a = t0[j];
                const float x0 = qv[NS - 2][j], x1 = qv[NS - 1][j];
                qv[NS - 2][j] = x0 * a.x - x1 * a.y; qv[NS - 1][j] = x1 * a.x + x0 * a.y;
            }
        }
#pragma unroll
        for (int s = 0; s < NS; ++s) {
            float tmp[8];
#pragma unroll
            for (int j = 0; j < 8; ++j) tmp[j] = qv[s][j] * sc;
            qf[qt][s] = __builtin_bit_cast(bf16x8, pack8(tmp));
        }
    }

    const bf16_t* kbase; long kstride; const bf16_t* vbase; const bf16_t* krbase = nullptr;
    if (TYPE == 0) { kbase = P.z + (long)b * SEQ * IN_COLS + OFF_AK + kvh * 64; kstride = IN_COLS; vbase = P.vtA + (long)((b * 2 + kvh) * 64) * SEQ; }
    else if (TYPE == 1) { kbase = P.z + (long)b * SEQ * IN_COLS + OFF_BK + kvh * 64; kstride = IN_COLS; vbase = P.vtB + (long)((b * 2 + kvh) * 64) * SEQ; }
    else { kbase = P.kc + (long)b * SEQ * 256 + head * 64; kstride = 256; vbase = P.vtC + (long)((b * 4 + head) * 64) * SEQ; krbase = P.z + (long)b * SEQ * IN_COLS + OFF_CKR; }
    int kt_lo = 0, kt_hi = 32;
    if (TYPE == 1) { kt_lo = qb * (2 * NQT) - 2; if (kt_lo < 0) kt_lo = 0; kt_hi = qb * (2 * NQT) + 2 * NQT + 2; if (kt_hi > 32) kt_hi = 32; }

    const bf16_t* krp = (TYPE == 2) ? krbase : nullptr;
    constexpr int BUF = 20480;
#define ATT_STAGE(buf_, kt_)                                                                             \
    {                                                                                                    \
        char* ls_ = lds + (buf_) * BUF;                                                                  \
        glds_rows128<64>(kbase + (long)((kt_) * 64) * kstride, kstride, ls_, tid);                       \
        glds_rows128<64>(vbase + (kt_) * 64, SEQ, ls_ + 8192, tid);                                      \
        if (TYPE == 2) glds_rows64(krp + (long)((kt_) * 64) * IN_COLS, IN_COLS, ls_ + 16384, tid);       \
    }

    const int pr = (r & 0x13) | ((r & 4) << 1) | ((r & 8) >> 1);
    int koff[NS];
#pragma unroll
    for (int s = 0; s < NS; ++s) {
        if (s < 4) koff[s] = pr * 128 + (((2 * s + h) ^ ((pr >> 1) & 7)) << 4);
        else koff[s] = 16384 + pr * 64 + (((2 * (s - 4) + h) ^ ((pr >> 2) & 3)) << 4);
    }
    int voff[2][2];
#pragma unroll
    for (int c = 0; c < 2; ++c)
#pragma unroll
        for (int s2 = 0; s2 < 2; ++s2) voff[c][s2] = 8192 + r * 128 + (((4 * c + 2 * s2 + h) ^ ((r >> 1) & 7)) << 4);

    f32x16 O[NQT][2];
#pragma unroll
    for (int a = 0; a < NQT; ++a)
#pragma unroll
        for (int d = 0; d < 2; ++d)
#pragma unroll
            for (int i = 0; i < 16; ++i) O[a][d][i] = 0.f;
    float m[NQT], lsum[NQT];
#pragma unroll
    for (int a = 0; a < NQT; ++a) {
        if (TYPE == 1) { m[a] = P.b_sink[l * 6 + head] * LOG2E; lsum[a] = (h == 0) ? 1.f : 0.f; }
        else { m[a] = -INFINITY; lsum[a] = 0.f; }
    }

    constexpr int GL = (TYPE == 2) ? 5 : 4;
    ATT_STAGE(0, kt_lo);
    if (kt_lo + 1 < kt_hi) ATT_STAGE(1, kt_lo + 1);
    int cur = 0, nx2 = 2;
    for (int kt = kt_lo; kt < kt_hi; ++kt) {
        if (kt + 1 < kt_hi) asm volatile("s_waitcnt vmcnt(%0)" ::"n"(GL) : "memory");
        else asm volatile("s_waitcnt vmcnt(0)" ::: "memory");
        __builtin_amdgcn_s_barrier();
        asm volatile("" ::: "memory");
        if (kt + 2 < kt_hi) ATT_STAGE(nx2, kt + 2);
        const char* lb = lds + cur * BUF;
        cur = (cur == 2) ? 0 : cur + 1;
        nx2 = (nx2 == 2) ? 0 : nx2 + 1;
        bool active = true;
        if (TYPE == 1) active = (kt * 64 + 63 >= q0 - 128) && (kt * 64 <= q0 + 32 * NQT - 1 + 128);
#pragma unroll
        for (int c = 0; c < 2; ++c) {
            if (active) {
#pragma unroll
                for (int qt = 0; qt < NQT; ++qt) {
                    bool need_mask = false;
                    if (TYPE == 1) {
                        const int qlo = q0 + qt * 32, klo = kt * 64 + c * 32;
                        if (klo - (qlo + 31) > 128 || qlo - (klo + 31) > 128) continue;
                        need_mask = (klo + 31 - qlo > 128) || (qlo + 31 - klo > 128);
                    }
                    f32x16 S;
#pragma unroll
                    for (int i = 0; i < 16; ++i) S[i] = 0.f;
#pragma unroll
                    for (int s = 0; s < NS; ++s) {
                        const bf16x8 kf = *(const bf16x8*)(lb + koff[s] + c * ((s < 4) ? 4096 : 2048));
                        S = MFMA32(kf, qf[qt][s], S);
                    }
                    if (TYPE == 1 && need_mask) {
                        const int qpos = q0 + qt * 32 + r;
                        const int kb0 = kt * 64 + c * 32 + 8 * h;
#pragma unroll
                        for (int i = 0; i < 16; ++i) {
                            const int key = kb0 + (i & 3) + 4 * ((i >> 2) & 1) + 16 * (i >> 3);
                            const int d = qpos - key;
                            if (d > 128 || d < -128) S[i] = -1e30f;
                        }
                    }
                    float mx = S[0];
#pragma unroll
                    for (int i = 1; i < 16; ++i) mx = fmaxf(mx, S[i]);
                    mx = xhalf_max(mx);
                    if (__builtin_amdgcn_ballot_w64(mx - m[qt] > 6.0f) != 0) {
                        const float mnew = fmaxf(m[qt], mx);
                        const float alpha = __builtin_amdgcn_exp2f(m[qt] - mnew);
                        m[qt] = mnew;
                        lsum[qt] *= alpha;
#pragma unroll
                        for (int d = 0; d < 2; ++d)
#pragma unroll
                            for (int i = 0; i < 16; ++i) O[qt][d][i] *= alpha;
                    }
                    const float mcur = m[qt];
                    float rs = 0.f;
#pragma unroll
                    for (int i = 0; i < 16; ++i) { const float p = __builtin_amdgcn_exp2f(S[i] - mcur); S[i] = p; rs += p; }
                    lsum[qt] += rs;
#pragma unroll
                    for (int s2 = 0; s2 < 2; ++s2) {
                        u32x4 pp;
#pragma unroll
                        for (int k = 0; k < 4; ++k) pp[k] = pk2(S[8 * s2 + 2 * k], S[8 * s2 + 2 * k + 1]);
                        const bf16x8 pf = __builtin_bit_cast(bf16x8, pp);
#pragma unroll
                        for (int dvt = 0; dvt < 2; ++dvt) {
                            const bf16x8 vf = *(const bf16x8*)(lb + voff[c][s2] + dvt * 4096);
                            O[qt][dvt] = MFMA32(vf, pf, O[qt][dvt]);
                        }
                    }
                }
            }
        }
    }
    __syncthreads();

    bf16_t* og = P.xb;
    {
        const int tid2 = opaque_tid(), r2 = tid2 & 31, h2 = (tid2 >> 5) & 1;
        const int q02 = qb * (128 * NQT) + (tid2 >> 6) * (32 * NQT);
#pragma unroll
        for (int qt = 0; qt < NQT; ++qt) {
            const float lt = xhalf_sum(lsum[qt]);
            const float inv = 1.0f / lt;
            const long tok = (long)b * SEQ + q02 + qt * 32 + r2;
            const bf16_t* gp = P.z + tok * IN_COLS + ((TYPE == 0) ? OFF_AG : (TYPE == 1) ? OFF_BG : OFF_CG) + head * 64;
            bf16_t* op = og + tok * 1024 + ((TYPE == 0) ? 0 : (TYPE == 1) ? 384 : 768) + head * 64;
            u32x2 graw[2][4];
#pragma unroll
            for (int dvt = 0; dvt < 2; ++dvt)
#pragma unroll
                for (int g4 = 0; g4 < 4; ++g4) graw[dvt][g4] = *(const u32x2*)(gp + dvt * 32 + 8 * g4 + 4 * h2);
#pragma unroll
            for (int dvt = 0; dvt < 2; ++dvt)
#pragma unroll
                for (int g4 = 0; g4 < 4; ++g4) {
                    const int dv = dvt * 32 + 8 * g4 + 4 * h2;
                    const float gv0 = bflo(graw[dvt][g4][0]), gv1 = bfhi(graw[dvt][g4][0]), gv2 = bflo(graw[dvt][g4][1]), gv3 = bfhi(graw[dvt][g4][1]);
                    const float o0 = O[qt][dvt][4 * g4 + 0] * inv * (gv0 / (1.0f + __expf(-gv0)));
                    const float o1 = O[qt][dvt][4 * g4 + 1] * inv * (gv1 / (1.0f + __expf(-gv1)));
                    const float o2 = O[qt][dvt][4 * g4 + 2] * inv * (gv2 / (1.0f + __expf(-gv2)));
                    const float o3 = O[qt][dvt][4 * g4 + 3] * inv * (gv3 / (1.0f + __expf(-gv3)));
                    u32x2 o; o[0] = pk2(o0, o1); o[1] = pk2(o2, o3);
                    *(u32x2*)(op + dv) = o;
                }
        }
    }
#undef ATT_STAGE
}

DI void phase_attn(const Params& P, int l, char* lds) {
    for_items(NBATCH * 160, [&](int id) {
        const int b = id / 160, w = id % 160;
        if (w < 48) { const int g = w % 3, qb = (w / 3) & 7, kvh = w / 24; attn_item<0, 2>(P, l, b, kvh * 3 + g, kvh, qb, lds); }
        else if (w < 112) { const int u = w - 48; attn_item<2, 1>(P, l, b, u & 3, 0, u >> 2, lds); }
        else { const int u = w - 112; const int g = u % 3, qb = (u / 3) & 7, kvh = u / 24; attn_item<1, 2>(P, l, b, kvh * 3 + g, kvh, qb, lds); }
    });
}

constexpr int N_PHASES = 13;
DI void run_phase(const Params& P, int ph, char* lds) {
    if (ph == 0) { phase_prep(P); phase_norm<false>(P.x, P.xb, nullptr, nullptr); return; }
    if (ph == 12) { phase_norm<true>(P.out, nullptr, P.out, P.final_g); return; }
    const int l = (ph >= 6) ? 1 : 0;
    const int sub = ph - 6 * l;
    if (sub == 0) { phase_norm<false>(P.out, P.xb, nullptr, nullptr); return; }
    if (sub == 1) {
        GemmArgs g{P.xb, 1024, P.winT + (long)l * IN_PAD * 1024, 1024, 1024};
        EpiZ epi{P.z, P.vtA, P.vtB};
        for_items(256 * 21, [&](int t) { gemm_tile(g, (t / 21) * 128, (t % 21) * 128, lds, epi); });
        return;
    }
    if (sub == 2) { phase_kprep(P, l); return; }
    if (sub == 3) {
        GemmArgs gq{P.z + OFF_CQ, IN_COLS, P.wuqT + (long)l * 384 * 192, 192, 192};
        GemmArgs gk{P.z + OFF_CKV, IN_COLS, P.wukvT + (long)l * 512 * 128, 128, 128};
        EpiQC eq{P.qc};
        EpiKV ek{P.kc, P.vtC};
        for_items(256 * 8, [&](int t) {
            const int mt = t >> 3, n = t & 7;
            if (n < 3) gemm_tile(gq, mt * 128, n * 128, lds, eq);
            else if (n < 7) gemm_tile(gk, mt * 128, (n - 3) * 128, lds, ek);
        });
        return;
    }
    if (sub == 4) { phase_attn(P, l, lds); return; }
    if (sub == 5) {
        GemmArgs g{P.xb, 1024, P.woutT + (long)l * 1024 * 1024, 1024, 1024};
        EpiOut epi{(l == 0) ? P.x : P.out, P.out};
        for_items(256 * 8, [&](int t) { gemm_tile(g, (t >> 3) * 128, (t & 7) * 128, lds, epi); });
        return;
    }
}

template <bool COOP>
__global__ void __launch_bounds__(256, 2) mega(Params P, int plo, int phi) {
    __shared__ __attribute__((aligned(16))) char lds[65536];
    if (COOP) {
        __shared__ uint4 xb_words;
        if (threadIdx.x == 0) xb_words = make_uint4(0u, 0u, 0u, 0u);
        __syncthreads();
        XcdBarrier xb = xcd_barrier_post(P.bar, (volatile LAS unsigned*)&xb_words);
        for (int ph = plo; ph < phi; ++ph) {
            run_phase(P, ph, lds);
            if ((REP_MASK >> ph) & 1) { xcd_barrier(xb); run_phase(P, ph, lds); }
            if (ph + 1 < phi) {
                if (plo < 0) cg::this_grid().sync();
                xcd_barrier(xb);
            }
        }
    } else {
        for (int ph = plo; ph < phi; ++ph) run_phase(P, ph, lds);
    }
}

extern "C" void kernel_launch(void* const* d_in, const int* in_sizes, int n_in, void* d_out, int out_size, void* d_ws, size_t ws_size, hipStream_t stream) {
    Params P{};
    P.x = (const float*)d_in[0]; P.norm_g = (const float*)d_in[1]; P.w_in = (const float*)d_in[2]; P.a_qn = (const float*)d_in[3];
    P.a_kn = (const float*)d_in[4]; P.b_sink = (const float*)d_in[5]; P.c_qn = (const float*)d_in[6]; P.c_kvn = (const float*)d_in[7];
    P.c_wuq = (const float*)d_in[8]; P.c_wukv = (const float*)d_in[9]; P.w_out = (const float*)d_in[10]; P.final_g = (const float*)d_in[11];
    P.out = (float*)d_out;
    char* w = (char*)d_ws;
    size_t off = 0;
    auto take = [&](size_t bytes) { char* p = w + off; off += (bytes + 255) & ~(size_t)255; return p; };
    P.xb = (bf16_t*)take((size_t)NTOK * 1024 * 2);
    P.z = (bf16_t*)take((size_t)NTOK * IN_COLS * 2);
    P.qc = (bf16_t*)take((size_t)NTOK * 384 * 2);
    P.kc = (bf16_t*)take((size_t)NTOK * 256 * 2);
    P.vtA = (bf16_t*)take((size_t)NBATCH * 2 * 64 * SEQ * 2);
    P.vtB = (bf16_t*)take((size_t)NBATCH * 2 * 64 * SEQ * 2);
    P.vtC = (bf16_t*)take((size_t)NBATCH * 4 * 64 * SEQ * 2);
    P.winT = (bf16_t*)take((size_t)2 * IN_PAD * 1024 * 2);
    P.woutT = (bf16_t*)take((size_t)2 * 1024 * 1024 * 2);
    P.wuqT = (bf16_t*)take((size_t)2 * 384 * 192 * 2);
    P.wukvT = (bf16_t*)take((size_t)2 * 512 * 128 * 2);
    P.t32 = (float2*)take((size_t)2048 * 48 * 8);
    P.bar = (unsigned*)take((size_t)XCD_BAR_WORDS * 4);
    if (off > ws_size) { fprintf(stderr, "workspace too small: need %zu have %zu\n", off, ws_size); return; }

    static int grid_blocks = 0;
    if (!grid_blocks) {
        int dev = 0, cus = 0, per_cu = 0;
        hipGetDevice(&dev);
        hipDeviceGetAttribute(&cus, hipDeviceAttributeMultiprocessorCount, dev);
#if MK_COOP
        hipOccupancyMaxActiveBlocksPerMultiprocessor(&per_cu, mega<true>, 256, 0);
#else
        hipOccupancyMaxActiveBlocksPerMultiprocessor(&per_cu, mega<false>, 256, 0);
#endif
        if (per_cu < 1) per_cu = 1;
        if (per_cu > 2) per_cu = 2;
        grid_blocks = cus * per_cu;
    }
#if MK_COOP
    hipMemsetAsync(P.bar, 0, XCD_BAR_WORDS * 4, stream);
    int plo = 0, phi = N_PHASES;
    void* args[] = {&P, &plo, &phi};
    hipError_t e = hipLaunchCooperativeKernel((void*)mega<true>, dim3(grid_blocks), dim3(256), args, 0, stream);
    if (e != hipSuccess) fprintf(stderr, "cooperative launch failed: %s (grid %d)\n", hipGetErrorString(e), grid_blocks);
#else
    for (int ph = 0; ph < N_PHASES; ++ph) mega<false><<<dim3(grid_blocks), dim3(256), 0, stream>>>(P, ph, ph + 1);
#endif
}
#ifdef RES_PROBE
__global__ void __launch_bounds__(256, 2) probe_prep(Params P) { phase_prep(P); }
__global__ void __launch_bounds__(256, 2) probe_norm(Params P) { phase_norm<false>(P.x, P.xb, nullptr, nullptr); }
__global__ void __launch_bounds__(256, 2) probe_kprep(Params P) { phase_kprep(P, 1); }
__global__ void __launch_bounds__(256, 2) probe_gemmz(Params P) { __shared__ __attribute__((aligned(16))) char lds[65536]; run_phase(P, 1, lds); }
__global__ void __launch_bounds__(256, 2) probe_gemmc(Params P) { __shared__ __attribute__((aligned(16))) char lds[65536]; run_phase(P, 3, lds); }
__global__ void __launch_bounds__(256, 2) probe_gemmo(Params P) { __shared__ __attribute__((aligned(16))) char lds[65536]; run_phase(P, 5, lds); }
__global__ void __launch_bounds__(256, 2) probe_attn0(Params P, int a, int b, int c) { __shared__ __attribute__((aligned(16))) char lds[65536]; attn_item<0, 2>(P, 1, a, b, c, 3, lds); }
__global__ void __launch_bounds__(256, 2) probe_attn1(Params P, int a, int b, int c) { __shared__ __attribute__((aligned(16))) char lds[65536]; attn_item<1, 2>(P, 1, a, b, c, 3, lds); }
__global__ void __launch_bounds__(256, 2) probe_attn2(Params P, int a, int b, int c) { __shared__ __attribute__((aligned(16))) char lds[65536]; attn_item<2, 1>(P, 1, a, b, c, 3, lds); }
#endif
```

```cpp
#include <hip/hip_runtime.h>
#include <hip/hip_cooperative_groups.h>
#include <stdint.h>
#include <cstdio>
namespace cg = cooperative_groups;

#ifndef REP_MASK
#define REP_MASK 0
#endif
#ifndef MK_COOP
#define MK_COOP 1
#endif

#define DI __device__ __forceinline__
typedef unsigned short bf16_t;
typedef short bf16x8 __attribute__((ext_vector_type(8)));
typedef float f32x16 __attribute__((ext_vector_type(16)));
typedef unsigned u32x4 __attribute__((ext_vector_type(4)));
typedef unsigned u32x2 __attribute__((ext_vector_type(2)));
typedef __bf16 bf2_t __attribute__((ext_vector_type(2)));
typedef float f2_t __attribute__((ext_vector_type(2)));

constexpr int D_MODEL = 1024, SEQ = 2048, NBATCH = 16, NTOK = NBATCH * SEQ;
constexpr int IN_COLS = 2656, IN_PAD = 2688;
constexpr int OFF_AQ = 0, OFF_AK = 384, OFF_AV = 512, OFF_AG = 640, OFF_BQ = 1024, OFF_BK = 1408, OFF_BV = 1536,
              OFF_BG = 1664, OFF_CQ = 2048, OFF_CKV = 2240, OFF_CKR = 2368, OFF_CG = 2400;
constexpr int T64_OFF = 2048 * 16;
constexpr float EPS = 1e-6f;
constexpr float LOG2E = 1.4426950408889634f;

struct Params {
    const float *x, *norm_g, *w_in, *a_qn, *a_kn, *b_sink, *c_qn, *c_kvn, *c_wuq, *c_wukv, *w_out, *final_g;
    float* out;
    bf16_t *xb, *z, *qc, *kc, *vtA, *vtB, *vtC, *winT, *woutT, *wuqT, *wukvT;
    unsigned* bar;
    float2 *t32;
};

DI unsigned pk2(float lo, float hi) { f2_t v = {lo, hi}; return __builtin_bit_cast(unsigned, __builtin_convertvector(v, bf2_t)); }
DI float bflo(unsigned u) { return __uint_as_float(u << 16); }
DI float bfhi(unsigned u) { return __uint_as_float(u & 0xffff0000u); }
DI void unpack8(const u32x4& raw, float* v) {
#pragma unroll
    for (int k = 0; k < 4; ++k) { v[2 * k] = bflo(raw[k]); v[2 * k + 1] = bfhi(raw[k]); }
}
DI u32x4 pack8(const float* v) { u32x4 o; o[0] = pk2(v[0], v[1]); o[1] = pk2(v[2], v[3]); o[2] = pk2(v[4], v[5]); o[3] = pk2(v[6], v[7]); return o; }
DI float wave_sum(float v) {
#pragma unroll
    for (int o = 32; o >= 1; o >>= 1) v += __shfl_xor(v, o);
    return v;
}

DI float xhalf_max(float x) { const auto p = __builtin_amdgcn_permlane32_swap(__float_as_uint(x), __float_as_uint(x), false, false); return fmaxf(__uint_as_float(p[0]), __uint_as_float(p[1])); }
DI float xhalf_sum(float x) { const auto p = __builtin_amdgcn_permlane32_swap(__float_as_uint(x), __float_as_uint(x), false, false); return __uint_as_float(p[0]) + __uint_as_float(p[1]); }
DI int opaque_tid() { int t = threadIdx.x; asm volatile("" : "+v"(t)); return t; }
DI int crow(int i, int h) { return (i & 3) + 8 * (i >> 2) + 4 * h; }

typedef __attribute__((address_space(3))) unsigned lds_u32;
template <int ROWS> DI void glds_rows128(const bf16_t* src, long row_stride, char* img, int tid) {
    const int lane = tid & 63, wid = tid >> 6;
#pragma unroll
    for (int k = 0; k < ROWS / 32; ++k) {
        const int p = wid + 4 * k;
        const int row = p * 8 + (lane >> 3), pc = lane & 7, lc = pc ^ ((row >> 1) & 7);
        __builtin_amdgcn_global_load_lds((const unsigned*)(src + (long)row * row_stride + lc * 8), (lds_u32*)(img + p * 1024 + lane * 16), 16, 0, 0);
    }
}
DI void glds_rows64(const bf16_t* src, long row_stride, char* img, int tid) {
    const int lane = tid & 63, wid = tid >> 6;
    const int row = wid * 16 + (lane >> 2), pc = lane & 3, lc = pc ^ ((row >> 2) & 3);
    __builtin_amdgcn_global_load_lds((const unsigned*)(src + (long)row * row_stride + lc * 8), (lds_u32*)(img + wid * 1024 + lane * 16), 16, 0, 0);
}
#define MFMA32(a, b, c) __builtin_amdgcn_mfma_f32_32x32x16_bf16((a), (b), (c), 0, 0, 0)

template <class F> DI void for_items(int total, F f) {
    if ((gridDim.x & 7) == 0 && (total & 7) == 0) {
        const int x = blockIdx.x & 7, j = blockIdx.x >> 3, nb = gridDim.x >> 3, per = total >> 3;
        for (int t = j; t < per; t += nb) f(x * per + t);
    } else {
        for (int t = blockIdx.x; t < total; t += gridDim.x) f(t);
    }
}


#define XB_TMO      128
#define XB_XCNT(j)  (256  + 64 * (j))
#define XB_XSUB(j)  (1280 + 64 * (j))
#define XB_XGEN(j)  (2304 + 64 * (j))
#define XB_TOP      3328
#define XB_TOPGEN   3392
#define XCD_BAR_WORDS 3456
#define XB_SPIN_CAP (1u << 18)
#define LAS __attribute__((address_space(3)))
DI unsigned xb_ld(unsigned* p)              { return __hip_atomic_load(p, __ATOMIC_RELAXED, __HIP_MEMORY_SCOPE_AGENT); }
DI unsigned xb_add(unsigned* p, unsigned v) { return __hip_atomic_fetch_add(p, v, __ATOMIC_RELAXED, __HIP_MEMORY_SCOPE_AGENT); }
DI unsigned xb_xcc_id() { return (unsigned)__builtin_amdgcn_s_getreg((3 << 11) | 20) & 0xFu; }
#define XB_SPIN(cond, bar) do { unsigned _sp = 0; while (cond) { __builtin_amdgcn_s_sleep(1); \
    if ((++_sp & 255u) == 0u) { if (xb_ld(&(bar)[XB_TMO])) break; if (_sp > XB_SPIN_CAP) { atomicAdd(&(bar)[XB_TMO], 1u); break; } } } } while (0)
struct XcdBarrier { unsigned* bar; unsigned x; volatile LAS unsigned* st; };
DI XcdBarrier xcd_barrier_post(unsigned* bar, volatile LAS unsigned* st) {
    XcdBarrier b; b.bar = bar; b.x = xb_xcc_id(); b.st = st;
    if (threadIdx.x == 0) (void)xb_add(&bar[XB_XCNT(b.x)], 1u);
    return b;
}
DI void xcd_barrier_complete(unsigned* bar, unsigned x, unsigned& nloc, unsigned& nx) {
    const unsigned G = gridDim.x * gridDim.y * gridDim.z;
    unsigned sum, cnt, mine, sp = 0u;
    for (;;) {
        sum = 0u; cnt = 0u; mine = 0u;
#pragma unroll
        for (unsigned j = 0; j < 16; ++j) { const unsigned c = xb_ld(&bar[XB_XCNT(j)]); sum += c; cnt += (c > 0u) ? 1u : 0u; mine = (j == x) ? c : mine; }
        if (sum == G) break;
        __builtin_amdgcn_s_sleep(1);
        if ((++sp & 255u) == 0u) { if (xb_ld(&bar[XB_TMO])) break; if (sp > XB_SPIN_CAP) { atomicAdd(&bar[XB_TMO], 1u); break; } }
    }
    nloc = mine > 0u ? mine : 1u; nx = cnt > 0u ? cnt : 1u;
}
DI void xcd_barrier(const XcdBarrier& b) {
    asm volatile("s_waitcnt vmcnt(0)" ::: "memory");
    __syncthreads();
    if (threadIdx.x == 0) {
        unsigned* bar = b.bar;
        __builtin_amdgcn_s_waitcnt(0);
        unsigned nloc = b.st[0], nx = b.st[1];
        if (nloc == 0u) { xcd_barrier_complete(bar, b.x, nloc, nx); b.st[0] = nloc; b.st[1] = nx; }
        const unsigned old = xb_add(&bar[XB_XSUB(b.x)], 1u);
        const unsigned gen = old / nloc;
        if (old + 1u == (gen + 1u) * nloc) {
            __builtin_amdgcn_fence(__ATOMIC_RELEASE, "agent");
            asm volatile("s_waitcnt vmcnt(0)" ::: "memory");
            const unsigned og = xb_add(&bar[XB_TOP], 1u);
            const unsigned tg = og / nx;
            if (og + 1u == (tg + 1u) * nx) xb_add(&bar[XB_TOPGEN], 1u);
            else XB_SPIN(xb_ld(&bar[XB_TOPGEN]) == tg, bar);
            __builtin_amdgcn_fence(__ATOMIC_ACQUIRE, "agent");
            xb_add(&bar[XB_XGEN(b.x)], 1u);
            asm volatile("s_waitcnt vmcnt(0)" ::: "memory");
        } else {
            XB_SPIN(xb_ld(&bar[XB_XGEN(b.x)]) == gen, bar);
            __builtin_amdgcn_fence(__ATOMIC_ACQUIRE, "agent");
            asm volatile("s_waitcnt vmcnt(0)" ::: "memory");
        }
    }
    __syncthreads();
}

DI void transpose_convert(const float* __restrict__ W, const float* __restrict__ scale, bf16_t* __restrict__ Wt, int K, int N, int Npad, long gtid, long gthreads) {
    const int KC = K >> 3;
    const long total = (long)Npad * KC;
    for (long it = gtid; it < total; it += gthreads) {
        const int n = (int)(it % Npad), kc = (int)(it / Npad);
        u32x4 o = {0u, 0u, 0u, 0u};
        if (n < N) {
            float v[8];
#pragma unroll
            for (int j = 0; j < 8; ++j) { const int k = kc * 8 + j; float w = W[(long)k * N + n]; if (scale) w *= scale[k]; v[j] = w; }
            o = pack8(v);
        }
        *(u32x4*)(Wt + (long)n * K + kc * 8) = o;
    }
}

DI void phase_prep(const Params& P) {
    const long gtid = (long)blockIdx.x * blockDim.x + opaque_tid(), gth = (long)gridDim.x * blockDim.x;
    for (int l = 0; l < 2; ++l) {
        transpose_convert(P.w_in + (long)l * 1024 * IN_COLS, P.norm_g + l * 1024, P.winT + (long)l * IN_PAD * 1024, 1024, IN_COLS, IN_PAD, gtid, gth);
        transpose_convert(P.w_out + (long)l * 1024 * 1024, nullptr, P.woutT + (long)l * 1024 * 1024, 1024, 1024, 1024, gtid, gth);
        transpose_convert(P.c_wuq + (long)l * 192 * 384, P.c_qn + l * 192, P.wuqT + (long)l * 384 * 192, 192, 384, 384, gtid, gth);
        transpose_convert(P.c_wukv + (long)l * 128 * 512, P.c_kvn + l * 128, P.wukvT + (long)l * 512 * 128, 128, 512, 512, gtid, gth);
    }
    for (long it = gtid; it < 2048 * 16; it += gth) {
        const int p = (int)(it >> 4), i = (int)(it & 15);
        const float inv = powf(10000.0f, -(float)i / 16.0f);
        const float ang = (float)p * inv;
        float s, c; sincosf(ang, &s, &c);
        P.t32[it] = make_float2(c, s);
    }
    for (long it = gtid; it < 2048 * 32; it += gth) {
        const int p = (int)(it >> 5), i = (int)(it & 31);
        const float inv = powf(10000.0f, -(float)i / 32.0f);
        const float ang = (float)p * inv;
        float s, c; sincosf(ang, &s, &c);
        P.t32[T64_OFF + it] = make_float2(c, s);
    }
}

template <bool FINAL> DI void phase_norm(const float* xin, bf16_t* xb, float* outp, const float* g) {
    const int tid = opaque_tid(), lane = tid & 63;
    const int gw = blockIdx.x * 4 + (tid >> 6), nw = gridDim.x * 4;
    constexpr int RW = 2;
    for (int row0 = gw * RW; row0 < NTOK; row0 += nw * RW) {
        float4 v[RW][4];
#pragma unroll
        for (int u = 0; u < RW; ++u) {
            const float4* p = (const float4*)(xin + (long)(row0 + u) * 1024);
#pragma unroll
            for (int i = 0; i < 4; ++i) v[u][i] = p[lane + 64 * i];
        }
        float4 gg[4];
        if (FINAL) {
#pragma unroll
            for (int i = 0; i < 4; ++i) gg[i] = ((const float4*)g)[lane + 64 * i];
        }
#pragma unroll
        for (int u = 0; u < RW; ++u) {
            float ss = 0.f;
#pragma unroll
            for (int i = 0; i < 4; ++i) ss += v[u][i].x * v[u][i].x + v[u][i].y * v[u][i].y + v[u][i].z * v[u][i].z + v[u][i].w * v[u][i].w;
            ss = wave_sum(ss);
            const float rinv = rsqrtf(ss * (1.0f / 1024.0f) + EPS);
            const long row = row0 + u;
#pragma unroll
            for (int i = 0; i < 4; ++i) {
                if (FINAL) {
                    float4 o; o.x = v[u][i].x * rinv * gg[i].x; o.y = v[u][i].y * rinv * gg[i].y; o.z = v[u][i].z * rinv * gg[i].z; o.w = v[u][i].w * rinv * gg[i].w;
                    ((float4*)(outp + row * 1024))[lane + 64 * i] = o;
                } else {
                    u32x2 o; o[0] = pk2(v[u][i].x * rinv, v[u][i].y * rinv); o[1] = pk2(v[u][i].z * rinv, v[u][i].w * rinv);
                    *(u32x2*)(xb + row * 1024 + (lane + 64 * i) * 4) = o;
                }
            }
        }
    }
}

struct GemmArgs { const bf16_t* A; int lda; const bf16_t* Bt; int ldb; int K; };

template <class Epi>
DI void gemm_tile(const GemmArgs& g, int m0, int n0, char* lds, const Epi& epi) {
    const int tid = opaque_tid(), lane = tid & 63, wid = tid >> 6, wm = wid >> 1, wn = wid & 1;
    const int r = lane & 31, h = lane >> 5;
    f32x16 acc[2][2];
#pragma unroll
    for (int a = 0; a < 2; ++a)
#pragma unroll
        for (int b = 0; b < 2; ++b)
#pragma unroll
            for (int i = 0; i < 16; ++i) acc[a][b][i] = 0.f;
    const bf16_t* ap = g.A + (long)m0 * g.lda;
    const bf16_t* bp = g.Bt + (long)n0 * g.ldb;
    const int nk = g.K >> 6;
    glds_rows128<128>(ap, g.lda, lds, tid);
    glds_rows128<128>(bp, g.ldb, lds + 16384, tid);
    __syncthreads();
    int arow[2], brow[2];
#pragma unroll
    for (int i = 0; i < 2; ++i) { arow[i] = wm * 64 + i * 32 + r; brow[i] = wn * 64 + i * 32 + r; }
    for (int kt = 0; kt < nk; ++kt) {
        if (kt + 1 < nk) {
            char* ls = lds + ((kt + 1) & 1) * 32768;
            glds_rows128<128>(ap + (kt + 1) * 64, g.lda, ls, tid);
            glds_rows128<128>(bp + (kt + 1) * 64, g.ldb, ls + 16384, tid);
        }
        const char* la = lds + (kt & 1) * 32768;
        const char* lb = la + 16384;
#pragma unroll
        for (int s = 0; s < 4; ++s) {
            bf16x8 af[2], bfr[2];
#pragma unroll
            for (int i = 0; i < 2; ++i) {
                af[i] = *(const bf16x8*)(la + arow[i] * 128 + (((2 * s + h) ^ ((arow[i] >> 1) & 7)) << 4));
                bfr[i] = *(const bf16x8*)(lb + brow[i] * 128 + (((2 * s + h) ^ ((brow[i] >> 1) & 7)) << 4));
            }
#pragma unroll
            for (int a = 0; a < 2; ++a)
#pragma unroll
                for (int b = 0; b < 2; ++b) acc[a][b] = MFMA32(bfr[b], af[a], acc[a][b]);
        }
        __syncthreads();
    }
    epi(acc, lds, m0, n0, tid);
    __syncthreads();
}

DI int img16(int row, int col) { return row * 256 + ((((col >> 3) ^ (row & 15))) << 4) + (col & 7) * 2; }
DI void epi_stage_bf16(const f32x16 (&acc)[2][2], char* img, int tid) {
    const int lane = tid & 63, wid = tid >> 6, wm = wid >> 1, wn = wid & 1, r = lane & 31, h = lane >> 5;
#pragma unroll
    for (int a = 0; a < 2; ++a)
#pragma unroll
        for (int b = 0; b < 2; ++b) {
            const int row = wm * 64 + a * 32 + r;
#pragma unroll
            for (int g4 = 0; g4 < 4; ++g4) {
                const int col = wn * 64 + b * 32 + 8 * g4 + 4 * h;
                u32x2 v; v[0] = pk2(acc[a][b][4 * g4], acc[a][b][4 * g4 + 1]); v[1] = pk2(acc[a][b][4 * g4 + 2], acc[a][b][4 * g4 + 3]);
                *(u32x2*)(img + img16(row, col)) = v;
            }
        }
}
DI void epi_stage_vt(const f32x16 (&acc)[2][2], char* img, int tid, int ncol0) {
    const int lane = tid & 63, wid = tid >> 6, wm = wid >> 1, wn = wid & 1, r = lane & 31, h = lane >> 5;
#pragma unroll
    for (int a = 0; a < 2; ++a)
#pragma unroll
        for (int b = 0; b < 2; ++b) {
            const int m = wm * 64 + a * 32 + r;
#pragma unroll
            for (int i = 0; i < 16; ++i) {
                const int n = wn * 64 + b * 32 + crow(i, h) - ncol0;
                *(bf16_t*)(img + img16(n, m)) = (bf16_t)(pk2(acc[a][b][i], 0.f) & 0xffffu);
            }
        }
}
template <int NROWS, int NCH> DI void epi_copy16(const char* img, bf16_t* dst0, long dstride, int tid, int ch_limit) {
    constexpr int LOG = (NCH == 16) ? 4 : 3;
#pragma unroll
    for (int k = 0; k < NROWS * NCH / 256; ++k) {
        const int idx = tid + 256 * k, row = idx >> LOG, ch = idx & (NCH - 1);
        const u32x4 v = *(const u32x4*)(img + row * 256 + ((ch ^ (row & 15)) << 4));
        if (ch < ch_limit) *(u32x4*)(dst0 + (long)row * dstride + ch * 8) = v;
    }
}

struct EpiZ {
    bf16_t *z, *vtA, *vtB;
    DI void operator()(const f32x16 (&acc)[2][2], char* lds, int m0, int n0, int tid) const {
        const int ntile = n0 >> 7;
        if (ntile == 4 || ntile == 12) {
            epi_stage_vt(acc, lds, tid, 0);
            __syncthreads();
            bf16_t* vt = (ntile == 4) ? vtA : vtB;
            const int b = m0 >> 11, t0 = m0 & 2047;
            epi_copy16<128, 16>(lds, vt + (long)(b * 2 * 64) * SEQ + t0, SEQ, tid, 16);
        } else {
            epi_stage_bf16(acc, lds, tid);
            __syncthreads();
            epi_copy16<128, 16>(lds, z + (long)m0 * IN_COLS + n0, IN_COLS, tid, (IN_COLS - n0) >> 3);
        }
    }
};
struct EpiQC {
    bf16_t* qc;
    DI void operator()(const f32x16 (&acc)[2][2], char* lds, int m0, int n0, int tid) const {
        epi_stage_bf16(acc, lds, tid);
        __syncthreads();
        epi_copy16<128, 16>(lds, qc + (long)m0 * 384 + n0, 384, tid, 16);
    }
};
struct EpiKV {
    bf16_t *kc, *vtC;
    DI void operator()(const f32x16 (&acc)[2][2], char* lds, int m0, int n0, int tid) const {
        const int head = n0 >> 7, wn = (tid >> 6) & 1;
        if (wn == 0) epi_stage_bf16(acc, lds, tid);
        else epi_stage_vt(acc, lds + 32768, tid, 64);
        __syncthreads();
        epi_copy16<128, 8>(lds, kc + (long)m0 * 256 + head * 64, 256, tid, 8);
        const int b = m0 >> 11, t0 = m0 & 2047;
        epi_copy16<64, 16>(lds + 32768, vtC + (long)((b * 4 + head) * 64) * SEQ + t0, SEQ, tid, 16);
    }
};
struct EpiOut {
    const float* xin; float* out;
    DI void operator()(const f32x16 (&acc)[2][2], char* lds, int m0, int n0, int tid) const {
        const int lane = tid & 63, wid = tid >> 6, wm = wid >> 1, wn = wid & 1, r = lane & 31, h = lane >> 5;
#pragma unroll
        for (int a = 0; a < 2; ++a)
#pragma unroll
            for (int b = 0; b < 2; ++b) {
                const int row = wm * 64 + a * 32 + r;
#pragma unroll
                for (int g4 = 0; g4 < 4; ++g4) {
                    const int ch = (wn * 64 + b * 32 + 8 * g4 + 4 * h) >> 2;
                    float4 v; v.x = acc[a][b][4 * g4]; v.y = acc[a][b][4 * g4 + 1]; v.z = acc[a][b][4 * g4 + 2]; v.w = acc[a][b][4 * g4 + 3];
                    *(float4*)(lds + row * 512 + ((ch ^ (row & 7)) << 4)) = v;
                }
            }
        __syncthreads();
#pragma unroll
        for (int k2 = 0; k2 < 2; ++k2) {
            float4 xv[8];
#pragma unroll
            for (int k = 0; k < 8; ++k) { const int idx = tid + 256 * (k2 * 8 + k), row = idx >> 5, ch = idx & 31; xv[k] = *(const float4*)(xin + (long)(m0 + row) * 1024 + n0 + ch * 4); }
#pragma unroll
            for (int k = 0; k < 8; ++k) {
                const int idx = tid + 256 * (k2 * 8 + k), row = idx >> 5, ch = idx & 31;
                const float4 v = *(const float4*)(lds + row * 512 + ((ch ^ (row & 7)) << 4));
                float4 o; o.x = xv[k].x + v.x; o.y = xv[k].y + v.y; o.z = xv[k].z + v.z; o.w = xv[k].w + v.w;
                *(float4*)(out + (long)(m0 + row) * 1024 + n0 + ch * 4) = o;
            }
        }
    }
};

DI void phase_kprep(const Params& P, int l) {
    const int tid = opaque_tid(), lane = tid & 63;
    const int gw = blockIdx.x * 4 + (tid >> 6), nw = gridDim.x * 4;
    constexpr int TK = 4;
    const int grp = (lane < 16) ? 0 : (lane < 32) ? 1 : 2;
    const int c = (grp == 2) ? (lane & 3) : (lane & 7);
    const int off1 = (grp == 0) ? OFF_AK + lane * 8 : (grp == 1) ? OFF_BK + (lane - 16) * 8 : OFF_CKR + (lane & 3) * 8;
    const int hl = lane & 31;
    const bool lo = lane < 32;
    const bool valid2 = lo ? (hl < 24) : (hl < 16);
    const int off2 = (lo ? OFF_CQ : OFF_CKV) + (valid2 ? hl : 0) * 8;
    const bool first = (grp == 1) ? (c < 4) : !(c & 2);
    float kn[8];
#pragma unroll
    for (int j = 0; j < 8; ++j) kn[j] = (grp == 0) ? P.a_kn[l * 64 + c * 8 + j] : 1.0f;
    for (int tok0 = gw * TK; tok0 < NTOK; tok0 += nw * TK) {
        u32x4 raw1[TK], raw2[TK];
        float2 cs[TK][8];
#pragma unroll
        for (int u = 0; u < TK; ++u) {
            const int tok = tok0 + u, t = tok & 2047;
            const bf16_t* zr = P.z + (long)tok * IN_COLS;
            raw1[u] = *(const u32x4*)(zr + off1);
            raw2[u] = *(const u32x4*)(zr + off2);
            int tidx;
            if (grp == 0) { const int pos = (c < 4) ? (t >> 6) : (t & 63); tidx = pos * 16 + (c & 1) * 8; }
            else if (grp == 1) tidx = T64_OFF + t * 32 + (c & 3) * 8;
            else tidx = t * 16 + (c & 1) * 8;
            const float2* tb = P.t32 + tidx;
#pragma unroll
            for (int j = 0; j < 8; ++j) cs[u][j] = tb[j];
        }
#pragma unroll
        for (int u = 0; u < TK; ++u) {
            bf16_t* zr = P.z + (long)(tok0 + u) * IN_COLS;
            {
                float v[8]; unpack8(raw1[u], v);
                float ss = 0.f;
#pragma unroll
                for (int j = 0; j < 8; ++j) ss += v[j] * v[j];
                ss += __shfl_xor(ss, 1); ss += __shfl_xor(ss, 2); ss += __shfl_xor(ss, 4);
                if (grp == 0) {
                    const float rinv = rsqrtf(ss * (1.0f / 64.0f) + EPS);
#pragma unroll
                    for (int j = 0; j < 8; ++j) v[j] = v[j] * rinv * kn[j];
                }
                float o[8];
#pragma unroll
                for (int j = 0; j < 8; ++j) {
                    const float p2 = __shfl_xor(v[j], 2), p4 = __shfl_xor(v[j], 4);
                    const float pv = (grp == 1) ? p4 : p2;
                    o[j] = v[j] * cs[u][j].x + (first ? -pv : pv) * cs[u][j].y;
                }
                if (lane < 36) *(u32x4*)(zr + off1) = pack8(o);
            }
            {
                float v[8]; unpack8(raw2[u], v);
                float ss = 0.f;
                if (valid2) {
#pragma unroll
                    for (int j = 0; j < 8; ++j) ss += v[j] * v[j];
                }
                ss += __shfl_xor(ss, 1); ss += __shfl_xor(ss, 2); ss += __shfl_xor(ss, 4); ss += __shfl_xor(ss, 8); ss += __shfl_xor(ss, 16);
                const float rinv = rsqrtf(ss * (lo ? (1.0f / 192.0f) : (1.0f / 128.0f)) + EPS);
#pragma unroll
                for (int j = 0; j < 8; ++j) v[j] *= rinv;
                if (valid2) *(u32x4*)(zr + off2) = pack8(v);
            }
        }
    }
}

template <int TYPE, int NQT>
DI void attn_item(const Params& P, int l, int b, int head, int kvh, int qb, char* lds) {
    constexpr int NS = (TYPE == 2) ? 6 : 4;
    const int tid = opaque_tid(), lane = tid & 63, wid = __builtin_amdgcn_readfirstlane(tid >> 6), r = lane & 31, h = lane >> 5;
    const int q0 = qb * (128 * NQT) + wid * (32 * NQT);
    const float sc = ((TYPE == 2) ? 0.10206207261596577f : 0.125f) * LOG2E;

    bf16x8 qf[NQT][NS];
#pragma unroll
    for (int qt = 0; qt < NQT; ++qt) {
        const int tq = q0 + qt * 32 + r;
        const long tok = (long)b * SEQ + tq;
        const bf16_t* src = (TYPE == 0) ? P.z + tok * IN_COLS + OFF_AQ + head * 64 : (TYPE == 1) ? P.z + tok * IN_COLS + OFF_BQ + head * 64 : P.qc + tok * 384 + head * 96;
        float qv[NS][8];
#pragma unroll
        for (int s = 0; s < NS; ++s) { const u32x4 raw = *(const u32x4*)(src + 16 * s + 8 * h); unpack8(raw, qv[s]); }
        if (TYPE == 0) {
            float ss = 0.f;
#pragma unroll
            for (int s = 0; s < 4; ++s)
#pragma unroll
                for (int j = 0; j < 8; ++j) ss += qv[s][j] * qv[s][j];
            ss = xhalf_sum(ss);
            const float rinv = rsqrtf(ss * (1.0f / 64.0f) + EPS);
#pragma unroll
            for (int s = 0; s < 4; ++s)
#pragma unroll
                for (int j = 0; j < 8; ++j) qv[s][j] *= rinv * P.a_qn[l * 64 + 16 * s + 8 * h + j];
            const float2* tr = P.t32 + (tq >> 6) * 16 + 8 * h;
            const float2* tc = P.t32 + (tq & 63) * 16 + 8 * h;
#pragma unroll
            for (int j = 0; j < 8; ++j) {
                const float2 a = tr[j], c2 = tc[j];
                const float x0 = qv[0][j], x1 = qv[1][j], y0 = qv[2][j], y1 = qv[3][j];
                qv[0][j] = x0 * a.x - x1 * a.y; qv[1][j] = x1 * a.x + x0 * a.y;
                qv[2][j] = y0 * c2.x - y1 * c2.y; qv[3][j] = y1 * c2.x + y0 * c2.y;
            }
        } else if (TYPE == 1) {
            const float2* t0 = P.t32 + T64_OFF + tq * 32 + 8 * h;
#pragma unroll
            for (int j = 0; j < 8; ++j) {
                const float2 a = t0[j], c2 = t0[16 + j];
                const float x0 = qv[0][j], x1 = qv[2][j], y0 = qv[1][j], y1 = qv[3][j];
                qv[0][j] = x0 * a.x - x1 * a.y; qv[2][j] = x1 * a.x + x0 * a.y;
                qv[1][j] = y0 * c2.x - y1 * c2.y; qv[3][j] = y1 * c2.x + y0 * c2.y;
            }
        } else {
            const float2* t0 = P.t32 + tq * 16 + 8 * h;
#pragma unroll
            for (int j = 0; j < 8; ++j) {
                const float2 a = t0[j];
                const float x0 = qv[NS - 2][j], x1 = qv[NS - 1][j];
                qv[NS - 2][j] = x0 * a.x - x1 * a.y; qv[NS - 1][j] = x1 * a.x + x0 * a.y;
            }
        }
#pragma unroll
        for (int s = 0; s < NS; ++s) {
            float tmp[8];
#pragma unroll
            for (int j = 0; j < 8; ++j) tmp[j] = qv[s][j] * sc;
            qf[qt][s] = __builtin_bit_cast(bf16x8, pack8(tmp));
        }
    }

    const bf16_t* kbase; long kstride; const bf16_t* vbase; const bf16_t* krbase = nullptr;
    if (TYPE == 0) { kbase = P.z + (long)b * SEQ * IN_COLS + OFF_AK + kvh * 64; kstride = IN_COLS; vbase = P.vtA + (long)((b * 2 + kvh) * 64) * SEQ; }
    else if (TYPE == 1) { kbase = P.z + (long)b * SEQ * IN_COLS + OFF_BK + kvh * 64; kstride = IN_COLS; vbase = P.vtB + (long)((b * 2 + kvh) * 64) * SEQ; }
    else { kbase = P.kc + (long)b * SEQ * 256 + head * 64; kstride = 256; vbase = P.vtC + (long)((b * 4 + head) * 64) * SEQ; krbase = P.z + (long)b * SEQ * IN_COLS + OFF_CKR; }
    int kt_lo = 0, kt_hi = 32;
    if (TYPE == 1) { kt_lo = qb * (2 * NQT) - 2; if (kt_lo < 0) kt_lo = 0; kt_hi = qb * (2 * NQT) + 2 * NQT + 2; if (kt_hi > 32) kt_hi = 32; }

    const bf16_t* krp = (TYPE == 2) ? krbase : nullptr;
    constexpr int BUF = 20480;
#define ATT_STAGE(buf_, kt_)                                                                             \
    {                                                                                                    \
        char* ls_ = lds + (buf_) * BUF;                                                                  \
        glds_rows128<64>(kbase + (long)((kt_) * 64) * kstride, kstride, ls_, tid);                       \
        glds_rows128<64>(vbase + (kt_) * 64, SEQ, ls_ + 8192, tid);                                      \
        if (TYPE == 2) glds_rows64(krp + (long)((kt_) * 64) * IN_COLS, IN_COLS, ls_ + 16384, tid);       \
    }

    const int pr = (r & 0x13) | ((r & 4) << 1) | ((r & 8) >> 1);
    int koff[NS];
#pragma unroll
    for (int s = 0; s < NS; ++s) {
        if (s < 4) koff[s] = pr * 128 + (((2 * s + h) ^ ((pr >> 1) & 7)) << 4);
        else koff[s] = 16384 + pr * 64 + (((2 * (s - 4) + h) ^ ((pr >> 2) & 3)) << 4);
    }
    int voff[2][2];
#pragma unroll
    for (int c = 0; c < 2; ++c)
#pragma unroll
        for (int s2 = 0; s2 < 2; ++s2) voff[c][s2] = 8192 + r * 128 + (((4 * c + 2 * s2 + h) ^ ((r >> 1) & 7)) << 4);

    f32x16 O[NQT][2];
#pragma unroll
    for (int a = 0; a < NQT; ++a)
#pragma unroll
        for (int d = 0; d < 2; ++d)
#pragma unroll
            for (int i = 0; i < 16; ++i) O[a][d][i] = 0.f;
    float m[NQT], lsum[NQT];
#pragma unroll
    for (int a = 0; a < NQT; ++a) {
        if (TYPE == 1) { m[a] = P.b_sink[l * 6 + head] * LOG2E; lsum[a] = (h == 0) ? 1.f : 0.f; }
        else { m[a] = -INFINITY; lsum[a] = 0.f; }
    }

    constexpr int GL = (TYPE == 2) ? 5 : 4;
    ATT_STAGE(0, kt_lo);
    if (kt_lo + 1 < kt_hi) ATT_STAGE(1, kt_lo + 1);
    int cur = 0, nx2 = 2;
    for (int kt = kt_lo; kt < kt_hi; ++kt) {
        if (kt + 1 < kt_hi) asm volatile("s_waitcnt vmcnt(%0)" ::"n"(GL) : "memory");
        else asm volatile("s_waitcnt vmcnt(0)" ::: "memory");
        __builtin_amdgcn_s_barrier();
        asm volatile("" ::: "memory");
        if (kt + 2 < kt_hi) ATT_STAGE(nx2, kt + 2);
        const char* lb = lds + cur * BUF;
        cur = (cur == 2) ? 0 : cur + 1;
        nx2 = (nx2 == 2) ? 0 : nx2 + 1;
        bool active = true;
        if (TYPE == 1) active = (kt * 64 + 63 >= q0 - 128) && (kt * 64 <= q0 + 32 * NQT - 1 + 128);
#pragma unroll
        for (int c = 0; c < 2; ++c) {
            if (active) {
#pragma unroll
                for (int qt = 0; qt < NQT; ++qt) {
                    bool need_mask = false;
                    if (TYPE == 1) {
                        const int qlo = q0 + qt * 32, klo = kt * 64 + c * 32;
                        if (klo - (qlo + 31) > 128 || qlo - (klo + 31) > 128) continue;
                        need_mask = (klo + 31 - qlo > 128) || (qlo + 31 - klo > 128);
                    }
                    f32x16 S;
#pragma unroll
                    for (int i = 0; i < 16; ++i) S[i] = 0.f;
#pragma unroll
                    for (int s = 0; s < NS; ++s) {
                        const bf16x8 kf = *(const bf16x8*)(lb + koff[s] + c * ((s < 4) ? 4096 : 2048));
                        S = MFMA32(kf, qf[qt][s], S);
                    }
                    if (TYPE == 1 && need_mask) {
                        const int qpos = q0 + qt * 32 + r;
                        const int kb0 = kt * 64 + c * 32 + 8 * h;
#pragma unroll
                        for (int i = 0; i < 16; ++i) {
                            const int key = kb0 + (i & 3) + 4 * ((i >> 2) & 1) + 16 * (i >> 3);
                            const int d = qpos - key;
                            if (d > 128 || d < -128) S[i] = -1e30f;
                        }
                    }
                    float mx = S[0];
#pragma unroll
                    for (int i = 1; i < 16; ++i) mx = fmaxf(mx, S[i]);
                    mx = xhalf_max(mx);
                    if (__builtin_amdgcn_ballot_w64(mx - m[qt] > 6.0f) != 0) {
                        const float mnew = fmaxf(m[qt], mx);
                        const float alpha = __builtin_amdgcn_exp2f(m[qt] - mnew);
                        m[qt] = mnew;
                        lsum[qt] *= alpha;
#pragma unroll
                        for (int d = 0; d < 2; ++d)
#pragma unroll
                            for (int i = 0; i < 16; ++i) O[qt][d][i] *= alpha;
                    }
                    const float mcur = m[qt];
                    float rs = 0.f;
#pragma unroll
                    for (int i = 0; i < 16; ++i) { const float p = __builtin_amdgcn_exp2f(S[i] - mcur); S[i] = p; rs += p; }
                    lsum[qt] += rs;
#pragma unroll
                    for (int s2 = 0; s2 < 2; ++s2) {
                        u32x4 pp;
#pragma unroll
                        for (int k = 0; k < 4; ++k) pp[k] = pk2(S[8 * s2 + 2 * k], S[8 * s2 + 2 * k + 1]);
                        const bf16x8 pf = __builtin_bit_cast(bf16x8, pp);
#pragma unroll
                        for (int dvt = 0; dvt < 2; ++dvt) {
                            const bf16x8 vf = *(const bf16x8*)(lb + voff[c][s2] + dvt * 4096);
                            O[qt][dvt] = MFMA32(vf, pf, O[qt][dvt]);
                        }
                    }
                }
            }
        }
    }
    __syncthreads();

    bf16_t* og = P.xb;
    {
        const int tid2 = opaque_tid(), r2 = tid2 & 31, h2 = (tid2 >> 5) & 1;
        const int q02 = qb * (128 * NQT) + (tid2 >> 6) * (32 * NQT);
#pragma unroll
        for (int qt = 0; qt < NQT; ++qt) {
            const float lt = xhalf_sum(lsum[qt]);
            const float inv = 1.0f / lt;
            const long tok = (long)b * SEQ + q02 + qt * 32 + r2;
            const bf16_t* gp = P.z + tok * IN_COLS + ((TYPE == 0) ? OFF_AG : (TYPE == 1) ? OFF_BG : OFF_CG) + head * 64;
            bf16_t* op = og + tok * 1024 + ((TYPE == 0) ? 0 : (TYPE == 1) ? 384 : 768) + head * 64;
            u32x2 graw[2][4];
#pragma unroll
            for (int dvt = 0; dvt < 2; ++dvt)
#pragma unroll
                for (int g4 = 0; g4 < 4; ++g4) graw[dvt][g4] = *(const u32x2*)(gp + dvt * 32 + 8 * g4 + 4 * h2);
#pragma unroll
            for (int dvt = 0; dvt < 2; ++dvt)
#pragma unroll
                for (int g4 = 0; g4 < 4; ++g4) {
                    const int dv = dvt * 32 + 8 * g4 + 4 * h2;
                    const float gv0 = bflo(graw[dvt][g4][0]), gv1 = bfhi(graw[dvt][g4][0]), gv2 = bflo(graw[dvt][g4][1]), gv3 = bfhi(graw[dvt][g4][1]);
                    const float o0 = O[qt][dvt][4 * g4 + 0] * inv * (gv0 / (1.0f + __expf(-gv0)));
                    const float o1 = O[qt][dvt][4 * g4 + 1] * inv * (gv1 / (1.0f + __expf(-gv1)));
                    const float o2 = O[qt][dvt][4 * g4 + 2] * inv * (gv2 / (1.0f + __expf(-gv2)));
                    const float o3 = O[qt][dvt][4 * g4 + 3] * inv * (gv3 / (1.0f + __expf(-gv3)));
                    u32x2 o; o[0] = pk2(o0, o1); o[1] = pk2(o2, o3);
                    *(u32x2*)(op + dv) = o;
                }
        }
    }
#undef ATT_STAGE
}

DI void phase_attn(const Params& P, int l, char* lds, volatile unsigned* sh_idx) {
    const int x = blockIdx.x & 7;
    unsigned* ctr = P.bar + XCD_BAR_WORDS + (l * 8 + x) * 16;
    for (;;) {
        __syncthreads();
        if (threadIdx.x == 0) *sh_idx = atomicAdd(ctr, 1u);
        __syncthreads();
        const int q = (int)__builtin_amdgcn_readfirstlane(*sh_idx);
        if (q >= 256) break;
        if (q < 64) { const int b = 2 * x + (q >> 5), v = q & 31; attn_item<2, 2>(P, l, b, v & 3, 0, v >> 2, lds); }
        else if (q < 160) { const int u = q - 64, b = 2 * x + u / 48, w = u % 48; const int g = w % 3, qb = (w / 3) & 7, kvh = w / 24; attn_item<0, 2>(P, l, b, kvh * 3 + g, kvh, qb, lds); }
        else { const int u = q - 160, b = 2 * x + u / 48, w = u % 48; const int g = w % 3, qb = (w / 3) & 7, kvh = w / 24; attn_item<1, 2>(P, l, b, kvh * 3 + g, kvh, qb, lds); }
    }
}

constexpr int N_PHASES = 13;
DI void run_phase(const Params& P, int ph, char* lds, volatile unsigned* sh_idx) {
    if (ph == 0) { phase_prep(P); phase_norm<false>(P.x, P.xb, nullptr, nullptr); return; }
    if (ph == 12) { phase_norm<true>(P.out, nullptr, P.out, P.final_g); return; }
    const int l = (ph >= 6) ? 1 : 0;
    const int sub = ph - 6 * l;
    if (sub == 0) { phase_norm<false>(P.out, P.xb, nullptr, nullptr); return; }
    if (sub == 1) {
        GemmArgs g{P.xb, 1024, P.winT + (long)l * IN_PAD * 1024, 1024, 1024};
        EpiZ epi{P.z, P.vtA, P.vtB};
        for_items(256 * 21, [&](int t) { gemm_tile(g, (t / 21) * 128, (t % 21) * 128, lds, epi); });
        return;
    }
    if (sub == 2) { phase_kprep(P, l); return; }
    if (sub == 3) {
        GemmArgs gq{P.z + OFF_CQ, IN_COLS, P.wuqT + (long)l * 384 * 192, 192, 192};
        GemmArgs gk{P.z + OFF_CKV, IN_COLS, P.wukvT + (long)l * 512 * 128, 128, 128};
        EpiQC eq{P.qc};
        EpiKV ek{P.kc, P.vtC};
        for_items(256 * 8, [&](int t) {
            const int mt = t >> 3, n = t & 7;
            if (n < 3) gemm_tile(gq, mt * 128, n * 128, lds, eq);
            else if (n < 7) gemm_tile(gk, mt * 128, (n - 3) * 128, lds, ek);
        });
        return;
    }
    if (sub == 4) { phase_attn(P, l, lds, sh_idx); return; }
    if (sub == 5) {
        GemmArgs g{P.xb, 1024, P.woutT + (long)l * 1024 * 1024, 1024, 1024};
        EpiOut epi{(l == 0) ? P.x : P.out, P.out};
        for_items(256 * 8, [&](int t) { gemm_tile(g, (t >> 3) * 128, (t & 7) * 128, lds, epi); });
        return;
    }
}

template <bool COOP>
__global__ void __launch_bounds__(256, 2) mega(Params P, int plo, int phi) {
    __shared__ __attribute__((aligned(16))) char lds[65536];
    __shared__ uint4 xb_words;
    volatile unsigned* sh_idx = (volatile unsigned*)&xb_words + 2;
    if (COOP) {
        if (threadIdx.x == 0) xb_words = make_uint4(0u, 0u, 0u, 0u);
        __syncthreads();
        XcdBarrier xb = xcd_barrier_post(P.bar, (volatile LAS unsigned*)&xb_words);
        for (int ph = plo; ph < phi; ++ph) {
            run_phase(P, ph, lds, sh_idx);
            if ((REP_MASK >> ph) & 1) { xcd_barrier(xb); run_phase(P, ph, lds, sh_idx); }
            if (ph + 1 < phi) {
                if (plo < 0) cg::this_grid().sync();
                xcd_barrier(xb);
            }
        }
    } else {
        for (int ph = plo; ph < phi; ++ph) run_phase(P, ph, lds, sh_idx);
    }
}

extern "C" void kernel_launch(void* const* d_in, const int* in_sizes, int n_in, void* d_out, int out_size, void* d_ws, size_t ws_size, hipStream_t stream) {
    Params P{};
    P.x = (const float*)d_in[0]; P.norm_g = (const float*)d_in[1]; P.w_in = (const float*)d_in[2]; P.a_qn = (const float*)d_in[3];
    P.a_kn = (const float*)d_in[4]; P.b_sink = (const float*)d_in[5]; P.c_qn = (const float*)d_in[6]; P.c_kvn = (const float*)d_in[7];
    P.c_wuq = (const float*)d_in[8]; P.c_wukv = (const float*)d_in[9]; P.w_out = (const float*)d_in[10]; P.final_g = (const float*)d_in[11];
    P.out = (float*)d_out;
    char* w = (char*)d_ws;
    size_t off = 0;
    auto take = [&](size_t bytes) { char* p = w + off; off += (bytes + 255) & ~(size_t)255; return p; };
    P.xb = (bf16_t*)take((size_t)NTOK * 1024 * 2);
    P.z = (bf16_t*)take((size_t)NTOK * IN_COLS * 2);
    P.qc = (bf16_t*)take((size_t)NTOK * 384 * 2);
    P.kc = (bf16_t*)take((size_t)NTOK * 256 * 2);
    P.vtA = (bf16_t*)take((size_t)NBATCH * 2 * 64 * SEQ * 2);
    P.vtB = (bf16_t*)take((size_t)NBATCH * 2 * 64 * SEQ * 2);
    P.vtC = (bf16_t*)take((size_t)NBATCH * 4 * 64 * SEQ * 2);
    P.winT = (bf16_t*)take((size_t)2 * IN_PAD * 1024 * 2);
    P.woutT = (bf16_t*)take((size_t)2 * 1024 * 1024 * 2);
    P.wuqT = (bf16_t*)take((size_t)2 * 384 * 192 * 2);
    P.wukvT = (bf16_t*)take((size_t)2 * 512 * 128 * 2);
    P.t32 = (float2*)take((size_t)2048 * 48 * 8);
    P.bar = (unsigned*)take((size_t)(XCD_BAR_WORDS + 256) * 4);
    if (off > ws_size) { fprintf(stderr, "workspace too small: need %zu have %zu\n", off, ws_size); return; }

    static int grid_blocks = 0;
    if (!grid_blocks) {
        int dev = 0, cus = 0, per_cu = 0;
        hipGetDevice(&dev);
        hipDeviceGetAttribute(&cus, hipDeviceAttributeMultiprocessorCount, dev);
#if MK_COOP
        hipOccupancyMaxActiveBlocksPerMultiprocessor(&per_cu, mega<true>, 256, 0);
#else
        hipOccupancyMaxActiveBlocksPerMultiprocessor(&per_cu, mega<false>, 256, 0);
#endif
        if (per_cu < 1) per_cu = 1;
        if (per_cu > 2) per_cu = 2;
        grid_blocks = cus * per_cu;
    }
#if MK_COOP
    hipMemsetAsync(P.bar, 0, (XCD_BAR_WORDS + 256) * 4, stream);
    int plo = 0, phi = N_PHASES;
    void* args[] = {&P, &plo, &phi};
    hipError_t e = hipLaunchCooperativeKernel((void*)mega<true>, dim3(grid_blocks), dim3(256), args, 0, stream);
    if (e != hipSuccess) fprintf(stderr, "cooperative launch failed: %s (grid %d)\n", hipGetErrorString(e), grid_blocks);
#else
    for (int ph = 0; ph < N_PHASES; ++ph) mega<false><<<dim3(grid_blocks), dim3(256), 0, stream>>>(P, ph, ph + 1);
#endif
}
#ifdef RES_PROBE
__global__ void __launch_bounds__(256, 2) probe_prep(Params P) { phase_prep(P); }
__global__ void __launch_bounds__(256, 2) probe_norm(Params P) { phase_norm<false>(P.x, P.xb, nullptr, nullptr); }
__global__ void __launch_bounds__(256, 2) probe_kprep(Params P) { phase_kprep(P, 1); }
__global__ void __launch_bounds__(256, 2) probe_gemmz(Params P) { __shared__ __attribute__((aligned(16))) char lds[65536]; run_phase(P, 1, lds); }
__global__ void __launch_bounds__(256, 2) probe_gemmc(Params P) { __shared__ __attribute__((aligned(16))) char lds[65536]; run_phase(P, 3, lds); }
__global__ void __launch_bounds__(256, 2) probe_gemmo(Params P) { __shared__ __attribute__((aligned(16))) char lds[65536]; run_phase(P, 5, lds); }
__global__ void __launch_bounds__(256, 2) probe_attn0(Params P, int a, int b, int c) { __shared__ __attribute__((aligned(16))) char lds[65536]; attn_item<0, 2>(P, 1, a, b, c, 3, lds); }
__global__ void __launch_bounds__(256, 2) probe_attn1(Params P, int a, int b, int c) { __shared__ __attribute__((aligned(16))) char lds[65536]; attn_item<1, 2>(P, 1, a, b, c, 3, lds); }
__global__ void __launch_bounds__(256, 2) probe_attn2(Params P, int a, int b, int c) { __shared__ __attribute__((aligned(16))) char lds[65536]; attn_item<2, 2>(P, 1, a, b, c, 3, lds); }
#endif
```

```cpp
#include <hip/hip_runtime.h>
#include <hip/hip_cooperative_groups.h>
#include <stdint.h>
#include <cstdio>
namespace cg = cooperative_groups;

#ifndef REP_MASK
#define REP_MASK 0
#endif
#ifndef MK_COOP
#define MK_COOP 1
#endif

#define DI __device__ __forceinline__
typedef unsigned short bf16_t;
typedef short bf16x8 __attribute__((ext_vector_type(8)));
typedef float f32x16 __attribute__((ext_vector_type(16)));
typedef unsigned u32x4 __attribute__((ext_vector_type(4)));
typedef unsigned u32x2 __attribute__((ext_vector_type(2)));
typedef __bf16 bf2_t __attribute__((ext_vector_type(2)));
typedef float f2_t __attribute__((ext_vector_type(2)));

constexpr int D_MODEL = 1024, SEQ = 2048, NBATCH = 16, NTOK = NBATCH * SEQ;
constexpr int IN_COLS = 2656, IN_PAD = 2816;
constexpr int NT = 512, NWV = 8;
constexpr int LDS_RING = 131072, LDS_RINV = LDS_RING + 16, LDS_BYTES = LDS_RINV + 1024;
constexpr int LDX = 1088, LDW = 1088, VTS = 2112, KCS = 320;
constexpr int OFF_AV = 0, OFF_BV = 128, OFF_AQ = 256, OFF_AK = 640, OFF_AG = 768, OFF_BQ = 1152, OFF_BK = 1536, OFF_BG = 1664,
              OFF_CQ = 2048, OFF_CKV = 2240, OFF_CKR = 2368, OFF_CG = 2400;
constexpr int T64_OFF = 2048 * 16;
constexpr float EPS = 1e-6f;
constexpr float LOG2E = 1.4426950408889634f;

#define XCD_BAR_WORDS 3456
constexpr size_t wsal(size_t b) { return (b + 255) & ~(size_t)255; }
constexpr size_t WS_xb = 0;
constexpr size_t WS_z = WS_xb + wsal((size_t)NTOK * LDX * 2);
constexpr size_t WS_qc = WS_z + wsal((size_t)NTOK * IN_COLS * 2);
constexpr size_t WS_kc = WS_qc + wsal((size_t)NTOK * 384 * 2);
constexpr size_t WS_vtA = WS_kc + wsal((size_t)NTOK * KCS * 2);
constexpr size_t WS_vtB = WS_vtA + wsal((size_t)NBATCH * 2 * 64 * VTS * 2);
constexpr size_t WS_vtC = WS_vtB + wsal((size_t)NBATCH * 2 * 64 * VTS * 2);
constexpr size_t WS_winT = WS_vtC + wsal((size_t)NBATCH * 4 * 64 * VTS * 2);
constexpr size_t WS_woutT = WS_winT + wsal((size_t)2 * IN_PAD * LDW * 2);
constexpr size_t WS_wuqT = WS_woutT + wsal((size_t)2 * 1024 * LDW * 2);
constexpr size_t WS_wukvT = WS_wuqT + wsal((size_t)2 * 512 * 192 * 2);
constexpr size_t WS_t32 = WS_wukvT + wsal((size_t)2 * 512 * 128 * 2);
constexpr size_t WS_bar = WS_t32 + wsal((size_t)2048 * 48 * 8);
constexpr size_t WS_xb2 = WS_bar + wsal((size_t)(XCD_BAR_WORDS + 512) * 4);
constexpr size_t WS_psum = WS_xb2 + wsal((size_t)NTOK * LDX * 2);
constexpr size_t WS_TOTAL = WS_psum + wsal((size_t)NTOK * 8 * 4);
struct Params {
    const float *x, *norm_g, *w_in, *a_qn, *a_kn, *b_sink, *c_qn, *c_kvn, *c_wuq, *c_wukv, *w_out, *final_g;
    float* out;
    char* ws;
    int wv, pad_;
    __host__ __device__ __forceinline__ bf16_t* xb() const { return (bf16_t*)(ws + WS_xb); }
    __host__ __device__ __forceinline__ bf16_t* z() const { return (bf16_t*)(ws + WS_z); }
    __host__ __device__ __forceinline__ bf16_t* qc() const { return (bf16_t*)(ws + WS_qc); }
    __host__ __device__ __forceinline__ bf16_t* kc() const { return (bf16_t*)(ws + WS_kc); }
    __host__ __device__ __forceinline__ bf16_t* vtA() const { return (bf16_t*)(ws + WS_vtA); }
    __host__ __device__ __forceinline__ bf16_t* vtB() const { return (bf16_t*)(ws + WS_vtB); }
    __host__ __device__ __forceinline__ bf16_t* vtC() const { return (bf16_t*)(ws + WS_vtC); }
    __host__ __device__ __forceinline__ bf16_t* winT() const { return (bf16_t*)(ws + WS_winT); }
    __host__ __device__ __forceinline__ bf16_t* woutT() const { return (bf16_t*)(ws + WS_woutT); }
    __host__ __device__ __forceinline__ bf16_t* wuqT() const { return (bf16_t*)(ws + WS_wuqT); }
    __host__ __device__ __forceinline__ bf16_t* wukvT() const { return (bf16_t*)(ws + WS_wukvT); }
    __host__ __device__ __forceinline__ float2* t32() const { return (float2*)(ws + WS_t32); }
    __host__ __device__ __forceinline__ unsigned* bar() const { return (unsigned*)(ws + WS_bar); }
    __host__ __device__ __forceinline__ bf16_t* xb2() const { return (bf16_t*)(ws + WS_xb2); }
    __host__ __device__ __forceinline__ float* psum() const { return (float*)(ws + WS_psum); }
};

typedef float f4v __attribute__((ext_vector_type(4)));
DI float4 ld_nt(const float* p) { const f4v v = __builtin_nontemporal_load((const f4v*)p); float4 o; o.x = v[0]; o.y = v[1]; o.z = v[2]; o.w = v[3]; return o; }
DI void st_nt(float* p, const float4& o) { f4v v; v[0] = o.x; v[1] = o.y; v[2] = o.z; v[3] = o.w; __builtin_nontemporal_store(v, (f4v*)p); }
DI unsigned pk2(float lo, float hi) { f2_t v = {lo, hi}; return __builtin_bit_cast(unsigned, __builtin_convertvector(v, bf2_t)); }
DI float bflo(unsigned u) { return __uint_as_float(u << 16); }
DI float bfhi(unsigned u) { return __uint_as_float(u & 0xffff0000u); }
DI void unpack8(const u32x4& raw, float* v) {
#pragma unroll
    for (int k = 0; k < 4; ++k) { v[2 * k] = bflo(raw[k]); v[2 * k + 1] = bfhi(raw[k]); }
}
DI u32x4 pack8(const float* v) { u32x4 o; o[0] = pk2(v[0], v[1]); o[1] = pk2(v[2], v[3]); o[2] = pk2(v[4], v[5]); o[3] = pk2(v[6], v[7]); return o; }
DI float wave_sum(float v) {
#pragma unroll
    for (int o = 32; o >= 1; o >>= 1) v += __shfl_xor(v, o);
    return v;
}

DI float xhalf_max(float x) { const auto p = __builtin_amdgcn_permlane32_swap(__float_as_uint(x), __float_as_uint(x), false, false); return fmaxf(__uint_as_float(p[0]), __uint_as_float(p[1])); }
DI float xhalf_sum(float x) { const auto p = __builtin_amdgcn_permlane32_swap(__float_as_uint(x), __float_as_uint(x), false, false); return __uint_as_float(p[0]) + __uint_as_float(p[1]); }
DI int opaque_tid(int wv) { int lane; asm volatile("v_mbcnt_lo_u32_b32 %0, -1, 0\n\tv_mbcnt_hi_u32_b32 %0, -1, %0" : "=v"(lane)); return wv * 64 + lane; }
DI int crow(int i, int h) { return (i & 3) + 8 * (i >> 2) + 4 * h; }

typedef __attribute__((address_space(3))) unsigned lds_u32;
template <int ROWS> DI void glds_rows128(const bf16_t* src, long row_stride, char* img, int tid) {
    const int lane = tid & 63, wid = tid >> 6;
#pragma unroll
    for (int k = 0; k < ROWS / 64; ++k) {
        const int p = wid + NWV * k;
        const int row = p * 8 + (lane >> 3), pc = lane & 7, lc = pc ^ ((row >> 1) & 7);
        __builtin_amdgcn_global_load_lds((const unsigned*)(src + (long)row * row_stride + lc * 8), (lds_u32*)(img + p * 1024 + lane * 16), 16, 0, 0);
    }
}
DI void glds_rows64(const bf16_t* src, long row_stride, char* img, int tid) {
    const int lane = tid & 63, wid = tid >> 6;
    if (wid < 4) {
        const int row = wid * 16 + (lane >> 2), pc = lane & 3, lc = pc ^ ((row >> 2) & 3);
        __builtin_amdgcn_global_load_lds((const unsigned*)(src + (long)row * row_stride + lc * 8), (lds_u32*)(img + wid * 1024 + lane * 16), 16, 0, 0);
    }
}
#define MFMA32(a, b, c) __builtin_amdgcn_mfma_f32_32x32x16_bf16((a), (b), (c), 0, 0, 0)

template <class F> DI void for_items(int total, F f) {
    if ((gridDim.x & 7) == 0 && (total & 7) == 0) {
        const int x = blockIdx.x & 7, j = blockIdx.x >> 3, nb = gridDim.x >> 3, per = total >> 3;
        for (int t = j; t < per; t += nb) f(x * per + t);
    } else {
        for (int t = blockIdx.x; t < total; t += gridDim.x) f(t);
    }
}


template <class F> DI void for_items_dyn(int total, unsigned* heads, volatile unsigned* sh_idx, int wv, F f) {
    const int x = blockIdx.x & 7, per = total >> 3;
    for (;;) {
        __syncthreads();
        if (opaque_tid(wv) == 0) *sh_idx = atomicAdd(heads + x * 16, 1u);
        __syncthreads();
        const int q = (int)__builtin_amdgcn_readfirstlane(*sh_idx);
        if (q >= per) break;
        f(x * per + q);
    }
}

#define XB_TMO      128
#define XB_XCNT(j)  (256  + 64 * (j))
#define XB_XSUB(j)  (1280 + 64 * (j))
#define XB_XGEN(j)  (2304 + 64 * (j))
#define XB_TOP      3328
#define XB_TOPGEN   3392
#define XB_SPIN_CAP (1u << 18)
#define LAS __attribute__((address_space(3)))
DI unsigned xb_ld(unsigned* p)              { return __hip_atomic_load(p, __ATOMIC_RELAXED, __HIP_MEMORY_SCOPE_AGENT); }
DI unsigned xb_add(unsigned* p, unsigned v) { return __hip_atomic_fetch_add(p, v, __ATOMIC_RELAXED, __HIP_MEMORY_SCOPE_AGENT); }
DI unsigned xb_xcc_id() { return (unsigned)__builtin_amdgcn_s_getreg((3 << 11) | 20) & 0xFu; }
#define XB_SPIN(cond, bar) do { unsigned _sp = 0; while (cond) { __builtin_amdgcn_s_sleep(1); \
    if ((++_sp & 255u) == 0u) { if (xb_ld(&(bar)[XB_TMO])) break; if (_sp > XB_SPIN_CAP) { atomicAdd(&(bar)[XB_TMO], 1u); break; } } } } while (0)
struct XcdBarrier { unsigned* bar; unsigned x; volatile LAS unsigned* st; int wv; };
DI XcdBarrier xcd_barrier_post(unsigned* bar, volatile LAS unsigned* st, int wv) {
    XcdBarrier b; b.bar = bar; b.x = xb_xcc_id(); b.st = st; b.wv = wv;
    if (opaque_tid(wv) == 0) (void)xb_add(&bar[XB_XCNT(b.x)], 1u);
    return b;
}
DI void xcd_barrier_complete(unsigned* bar, unsigned x, unsigned& nloc, unsigned& nx) {
    const unsigned G = gridDim.x * gridDim.y * gridDim.z;
    unsigned sum, cnt, mine, sp = 0u;
    for (;;) {
        sum = 0u; cnt = 0u; mine = 0u;
#pragma unroll
        for (unsigned j = 0; j < 16; ++j) { const unsigned c = xb_ld(&bar[XB_XCNT(j)]); sum += c; cnt += (c > 0u) ? 1u : 0u; mine = (j == x) ? c : mine; }
        if (sum == G) break;
        __builtin_amdgcn_s_sleep(1);
        if ((++sp & 255u) == 0u) { if (xb_ld(&bar[XB_TMO])) break; if (sp > XB_SPIN_CAP) { atomicAdd(&bar[XB_TMO], 1u); break; } }
    }
    nloc = mine > 0u ? mine : 1u; nx = cnt > 0u ? cnt : 1u;
}
DI void xcd_barrier(const XcdBarrier& b) {
    asm volatile("s_waitcnt vmcnt(0)" ::: "memory");
    __syncthreads();
    if (opaque_tid(b.wv) == 0) {
        unsigned* bar = b.bar;
        asm volatile("" : "+s"(bar));
        __builtin_amdgcn_s_waitcnt(0);
        unsigned nloc = b.st[0], nx = b.st[1];
        if (nloc == 0u) { xcd_barrier_complete(bar, b.x, nloc, nx); b.st[0] = nloc; b.st[1] = nx; }
        const unsigned old = xb_add(&bar[XB_XSUB(b.x)], 1u);
        const unsigned gen = old / nloc;
        if (old + 1u == (gen + 1u) * nloc) {
            __builtin_amdgcn_fence(__ATOMIC_RELEASE, "agent");
            asm volatile("s_waitcnt vmcnt(0)" ::: "memory");
            const unsigned og = xb_add(&bar[XB_TOP], 1u);
            const unsigned tg = og / nx;
            if (og + 1u == (tg + 1u) * nx) xb_add(&bar[XB_TOPGEN], 1u);
            else XB_SPIN(xb_ld(&bar[XB_TOPGEN]) == tg, bar);
            __builtin_amdgcn_fence(__ATOMIC_ACQUIRE, "agent");
            xb_add(&bar[XB_XGEN(b.x)], 1u);
            asm volatile("s_waitcnt vmcnt(0)" ::: "memory");
        } else {
            XB_SPIN(xb_ld(&bar[XB_XGEN(b.x)]) == gen, bar);
            __builtin_amdgcn_fence(__ATOMIC_ACQUIRE, "agent");
            asm volatile("s_waitcnt vmcnt(0)" ::: "memory");
        }
    }
    __syncthreads();
}

DI int zsrc_col(int n) { if (n < 128) return 512 + n; if (n < 256) return 1536 + (n - 128); const int m = n - 256; return (m < 512) ? m : (m < 1408) ? 640 + (m - 512) : 1664 + (m - 1408); }
template <bool ZPERM> DI void transpose_convert(const float* __restrict__ W, const float* __restrict__ scale, bf16_t* __restrict__ Wt, int K, int N, int Npad, int ldo, long gtid, long gthreads) {
    const int KC = K >> 3;
    const long total = (long)Npad * KC;
    for (long it = gtid; it < total; it += gthreads) {
        const int n = (int)(it % Npad), kc = (int)(it / Npad);
        u32x4 o = {0u, 0u, 0u, 0u};
        if (n < N) {
            float v[8];
            const int ns = ZPERM ? zsrc_col(n) : n;
#pragma unroll
            for (int j = 0; j < 8; ++j) { const int k = kc * 8 + j; float w = W[(long)k * N + ns]; if (scale) w *= scale[k]; v[j] = w; }
            o = pack8(v);
        }
        *(u32x4*)(Wt + (long)n * ldo + kc * 8) = o;
    }
}

DI void phase_prep(const Params& P) {
    const long gtid = (long)blockIdx.x * blockDim.x + opaque_tid(P.wv), gth = (long)gridDim.x * blockDim.x;
    for (int l = 0; l < 2; ++l) {
        transpose_convert<true>(P.w_in + (long)l * 1024 * IN_COLS, P.norm_g + l * 1024, P.winT() + (long)l * IN_PAD * LDW, 1024, IN_COLS, IN_PAD, LDW, gtid, gth);
        transpose_convert<false>(P.w_out + (long)l * 1024 * 1024, nullptr, P.woutT() + (long)l * 1024 * LDW, 1024, 1024, 1024, LDW, gtid, gth);
        transpose_convert<false>(P.c_wuq + (long)l * 192 * 384, P.c_qn + l * 192, P.wuqT() + (long)l * 512 * 192, 192, 384, 512, 192, gtid, gth);
        transpose_convert<false>(P.c_wukv + (long)l * 128 * 512, P.c_kvn + l * 128, P.wukvT() + (long)l * 512 * 128, 128, 512, 512, 128, gtid, gth);
    }
    for (long it = gtid; it < 2048 * 16; it += gth) {
        const int p = (int)(it >> 4), i = (int)(it & 15);
        const float inv = powf(10000.0f, -(float)i / 16.0f);
        const float ang = (float)p * inv;
        float s, c; sincosf(ang, &s, &c);
        P.t32()[it] = make_float2(c, s);
    }
    for (long it = gtid; it < 2048 * 32; it += gth) {
        const int p = (int)(it >> 5), i = (int)(it & 31);
        const float inv = powf(10000.0f, -(float)i / 32.0f);
        const float ang = (float)p * inv;
        float s, c; sincosf(ang, &s, &c);
        P.t32()[T64_OFF + it] = make_float2(c, s);
    }
}

template <bool FINAL> DI void phase_norm(const float* xin, bf16_t* xb, float* outp, const float* g, int wv) {
    const int tid = opaque_tid(wv), lane = tid & 63;
    const int gw = blockIdx.x * NWV + (tid >> 6), nw = gridDim.x * NWV;
    constexpr int RW = 2;
    for (int row0 = gw * RW; row0 < NTOK; row0 += nw * RW) {
        float4 v[RW][4];
#pragma unroll
        for (int u = 0; u < RW; ++u) {
            const float4* p = (const float4*)(xin + (long)(row0 + u) * 1024);
#pragma unroll
            for (int i = 0; i < 4; ++i) v[u][i] = ld_nt((const float*)(p + lane + 64 * i));
        }
        float4 gg[4];
        if (FINAL) {
#pragma unroll
            for (int i = 0; i < 4; ++i) gg[i] = ((const float4*)g)[lane + 64 * i];
        }
#pragma unroll
        for (int u = 0; u < RW; ++u) {
            float ss = 0.f;
#pragma unroll
            for (int i = 0; i < 4; ++i) ss += v[u][i].x * v[u][i].x + v[u][i].y * v[u][i].y + v[u][i].z * v[u][i].z + v[u][i].w * v[u][i].w;
            ss = wave_sum(ss);
            const float rinv = rsqrtf(ss * (1.0f / 1024.0f) + EPS);
            const long row = row0 + u;
#pragma unroll
            for (int i = 0; i < 4; ++i) {
                if (FINAL) {
                    float4 o; o.x = v[u][i].x * rinv * gg[i].x; o.y = v[u][i].y * rinv * gg[i].y; o.z = v[u][i].z * rinv * gg[i].z; o.w = v[u][i].w * rinv * gg[i].w;
                    st_nt(outp + row * 1024 + (lane + 64 * i) * 4, o);
                } else {
                    u32x2 o; o[0] = pk2(v[u][i].x * rinv, v[u][i].y * rinv); o[1] = pk2(v[u][i].z * rinv, v[u][i].w * rinv);
                    *(u32x2*)(xb + row * LDX + (lane + 64 * i) * 4) = o;
                }
            }
        }
    }
}

struct GemmArgs { const bf16_t* A; int lda; const bf16_t* Bt; int ldb; int K; int wv; };

template <class Epi>
DI void gemm_tile(const GemmArgs& g, int m0, int n0, char* lds, const Epi& epi) {
    const int tid = opaque_tid(g.wv), lane = tid & 63, wid = tid >> 6, wm = wid >> 2, wn = wid & 3;
    const int r = lane & 31, h = lane >> 5;
    f32x16 acc[4][2];
#pragma unroll
    for (int a = 0; a < 4; ++a)
#pragma unroll
        for (int b = 0; b < 2; ++b)
#pragma unroll
            for (int i = 0; i < 16; ++i) acc[a][b][i] = 0.f;
    const bf16_t* ap = g.A + (long)m0 * g.lda;
    const bf16_t* bp = g.Bt + (long)n0 * g.ldb;
    const int nk = g.K >> 6;
    glds_rows128<256>(ap, g.lda, lds, tid);
    glds_rows128<256>(bp, g.ldb, lds + 32768, tid);
    __syncthreads();
    int aoff[4], boff[2];
#pragma unroll
    for (int i = 0; i < 4; ++i) aoff[i] = (wm * 128 + i * 32 + r) * 128;
#pragma unroll
    for (int i = 0; i < 2; ++i) boff[i] = 32768 + (wn * 64 + i * 32 + r) * 128;
    const int swz = (r >> 1) & 7;
    for (int kt = 0; kt < nk; ++kt) {
        if (kt + 1 < nk) {
            char* ls = lds + ((kt + 1) & 1) * 65536;
            glds_rows128<256>(ap + (kt + 1) * 64, g.lda, ls, tid);
            glds_rows128<256>(bp + (kt + 1) * 64, g.ldb, ls + 32768, tid);
        }
        const char* st = lds + (kt & 1) * 65536;
#pragma unroll
        for (int s = 0; s < 4; ++s) {
            const int co = ((2 * s + h) ^ swz) << 4;
            bf16x8 af[4], bfr[2];
#pragma unroll
            for (int i = 0; i < 4; ++i) af[i] = *(const bf16x8*)(st + aoff[i] + co);
#pragma unroll
            for (int i = 0; i < 2; ++i) bfr[i] = *(const bf16x8*)(st + boff[i] + co);
#pragma unroll
            for (int a = 0; a < 4; ++a)
#pragma unroll
                for (int b = 0; b < 2; ++b) acc[a][b] = MFMA32(bfr[b], af[a], acc[a][b]);
        }
        __syncthreads();
    }
    epi(acc, lds, m0, n0, tid);
    __syncthreads();
}

DI int img32(int row, int col) { return row * 512 + ((((col >> 3) ^ (row & 31))) << 4) + (col & 7) * 2; }
DI int img16(int row, int col) { return row * 256 + ((((col >> 3) ^ (row & 15))) << 4) + (col & 7) * 2; }
template <bool W32> DI void epi_stage_rm(const f32x16 (&acc)[4][2], char* img, int tid, int cbase, const float* rtab) {
    const int lane = tid & 63, wid = tid >> 6, wm = wid >> 2, r = lane & 31, h = lane >> 5;
#pragma unroll
    for (int a = 0; a < 4; ++a)
#pragma unroll
        for (int b = 0; b < 2; ++b) {
            const int row = wm * 128 + a * 32 + r;
            const float rs = rtab[row];
#pragma unroll
            for (int g4 = 0; g4 < 4; ++g4) {
                const int col = cbase + b * 32 + 8 * g4 + 4 * h;
                u32x2 v; v[0] = pk2(acc[a][b][4 * g4] * rs, acc[a][b][4 * g4 + 1] * rs); v[1] = pk2(acc[a][b][4 * g4 + 2] * rs, acc[a][b][4 * g4 + 3] * rs);
                *(u32x2*)(img + (W32 ? img32(row, col) : img16(row, col))) = v;
            }
        }
}
DI void epi_stage_vt(const f32x16 (&acc)[4][2], char* img, int tid, int nbase, const float* rtab) {
    const int lane = tid & 63, wid = tid >> 6, wm = wid >> 2, r = lane & 31, h = lane >> 5;
#pragma unroll
    for (int a = 0; a < 4; ++a)
#pragma unroll
        for (int b = 0; b < 2; ++b) {
            const int m = wm * 128 + a * 32 + r;
            const float rs = rtab[m];
#pragma unroll
            for (int i = 0; i < 16; ++i) {
                const int n = nbase + b * 32 + crow(i, h);
                *(bf16_t*)(img + img32(n, m)) = (bf16_t)(pk2(acc[a][b][i] * rs, 0.f) & 0xffffu);
            }
        }
}


typedef float f32x4 __attribute__((ext_vector_type(4)));
namespace g8 {
constexpr int BM = 256, BK = 64, HALF = 128, HT = HALF * BK;
DI int lds_byte(int r, int c) { const int st = (r >> 4) * 2 + (c >> 5), rr = r & 15, cc = c & 31, ob = rr * 64 + cc * 2; return st * 1024 + (ob ^ (((ob >> 9) & 1) << 5)); }
DI void stage_rc(int b, int& R, int& C) { const int st = b / 1024, sb = b % 1024, swz = sb ^ (((sb >> 9) & 1) << 5); R = (st >> 1) * 16 + swz / 64; C = (st & 1) * 32 + (swz % 64) / 2; }
}
template <class Epi>
DI void gemm_tile8(const GemmArgs& g, int m0, int n0, char* lds, const Epi& epi) {
    using namespace g8;
    const bf16_t* A = g.A; const bf16_t* Bt = g.Bt;
    const long lda = g.lda, ldb = g.ldb;
    const int tid = opaque_tid(g.wv);
    const int wid = tid >> 6, lane = tid & 63, wr = wid >> 2, wc = wid & 3, fr = lane & 15, fq = lane >> 4;
    const int lane_off = lds_byte(fr, fq * 8);
    const char* a_rd = lds + wr * 8192 + lane_off;
    const char* b_rd = lds + 65536 + wc * 4096 + lane_off;
    int sr, sc; stage_rc(tid * 16, sr, sc);
    const unsigned a_src = (unsigned)((sr * (int)lda + sc) * 2);
    const unsigned b_src = (unsigned)((sr * (int)ldb + sc) * 2);
    char* st_dst = lds + tid * 16;
#define SA(b, h) (((b) * 2 + (h)) * 16384)
#define SB(b, h) (65536 + ((b) * 2 + (h)) * 16384)
#define STAGE(P_, BASE, LD, br, kt) do { const char* _gb = (const char*)((BASE) + (long)(br) * (LD) + (long)(kt) * BK); const unsigned _so = (&(BASE) == &A) ? a_src : b_src; \
    _Pragma("unroll") for (int _i = 0; _i < 2; ++_i) \
      __builtin_amdgcn_global_load_lds((const unsigned*)(_gb + (size_t)(_so + (unsigned)(_i * 128 * (int)(LD)))), (lds_u32*)(st_dst + (P_) + _i * 8192), 16, 0, 0); } while (0)
#define LDA(dst, b, h) _Pragma("unroll") for (int m = 0; m < 4; ++m) _Pragma("unroll") for (int k = 0; k < 2; ++k) \
    dst[m][k] = *reinterpret_cast<const bf16x8*>(a_rd + SA(b, h) + (2 * m + k) * 1024)
#define LDB(dst, b, h) _Pragma("unroll") for (int n = 0; n < 2; ++n) _Pragma("unroll") for (int k = 0; k < 2; ++k) \
    dst[n][k] = *reinterpret_cast<const bf16x8*>(b_rd + (SB(b, h) - 65536) + (2 * n + k) * 1024)
#define MMA(ai, bj, At_, Bt_) do { __builtin_amdgcn_s_setprio(1); \
    _Pragma("unroll") for (int m = 0; m < 4; ++m) _Pragma("unroll") for (int n = 0; n < 2; ++n) _Pragma("unroll") for (int k = 0; k < 2; ++k) \
      acc[ai][bj][m][n] = __builtin_amdgcn_mfma_f32_16x16x32_bf16(Bt_[n][k], At_[m][k], acc[ai][bj][m][n], 0, 0, 0); \
    __builtin_amdgcn_s_setprio(0); } while (0)
#define WAIT_V(n) asm volatile("s_waitcnt vmcnt(" #n ")" ::: "memory")
#define WAIT_L(n) asm volatile("s_waitcnt lgkmcnt(" #n ")" ::: "memory")
#define BAR __builtin_amdgcn_s_barrier()
#define SCHED __builtin_amdgcn_sched_barrier(0)
    const int brow = m0, bcol = n0;
    f32x4 acc[2][2][4][2];
#pragma unroll
    for (int a = 0; a < 2; ++a)
#pragma unroll
        for (int b = 0; b < 2; ++b)
#pragma unroll
            for (int m = 0; m < 4; ++m)
#pragma unroll
                for (int n = 0; n < 2; ++n) acc[a][b][m][n] = (f32x4){0.f, 0.f, 0.f, 0.f};
    bf16x8 At[4][2], B0[2][2], B1[2][2];
    const int nt = g.K / BK;
    STAGE(SB(0, 0), Bt, ldb, bcol, 0); STAGE(SA(0, 0), A, lda, brow, 0);
    STAGE(SB(0, 1), Bt, ldb, bcol + HALF, 0); STAGE(SA(0, 1), A, lda, brow + HALF, 0);
    if (wr == 1) BAR;
    WAIT_V(4); BAR;
    STAGE(SB(1, 0), Bt, ldb, bcol, 1); STAGE(SA(1, 0), A, lda, brow, 1); STAGE(SB(1, 1), Bt, ldb, bcol + HALF, 1);
    WAIT_V(6); BAR;
    for (int t = 0; t < nt - 2; t += 2) {
        LDB(B0, 0, 0); SCHED; LDA(At, 0, 0); STAGE(SA(1, 1), A, lda, brow + HALF, t + 1);
        WAIT_L(8); BAR; WAIT_L(0); MMA(0, 0, At, B0); BAR; SCHED;
        LDB(B1, 0, 1); STAGE(SB(0, 0), Bt, ldb, bcol, t + 2);
        BAR; WAIT_L(0); MMA(0, 1, At, B1); BAR;
        LDA(At, 0, 1); STAGE(SA(0, 0), A, lda, brow, t + 2);
        BAR; WAIT_L(0); MMA(1, 0, At, B0); BAR; SCHED;
        STAGE(SB(0, 1), Bt, ldb, bcol + HALF, t + 2);
        WAIT_V(6); BAR; MMA(1, 1, At, B1); BAR;
        LDB(B0, 1, 0); SCHED; LDA(At, 1, 0); STAGE(SA(0, 1), A, lda, brow + HALF, t + 2);
        WAIT_L(8); BAR; WAIT_L(0); MMA(0, 0, At, B0); BAR; SCHED;
        LDB(B1, 1, 1); STAGE(SB(1, 0), Bt, ldb, bcol, t + 3);
        BAR; WAIT_L(0); MMA(0, 1, At, B1); BAR;
        LDA(At, 1, 1); STAGE(SA(1, 0), A, lda, brow, t + 3);
        BAR; WAIT_L(0); MMA(1, 0, At, B0); BAR; SCHED;
        STAGE(SB(1, 1), Bt, ldb, bcol + HALF, t + 3);
        WAIT_V(6); BAR; MMA(1, 1, At, B1); BAR;
    }
    { LDB(B0, 0, 0); LDA(At, 0, 0); STAGE(SA(1, 1), A, lda, brow + HALF, nt - 1);
      BAR; WAIT_L(0); MMA(0, 0, At, B0); BAR;
      LDB(B1, 0, 1); BAR; WAIT_L(0); MMA(0, 1, At, B1); BAR;
      LDA(At, 0, 1); WAIT_V(4); BAR; WAIT_L(0); MMA(1, 0, At, B0); MMA(1, 1, At, B1); BAR; }
    { LDB(B0, 1, 0); LDA(At, 1, 0); WAIT_V(2); BAR; WAIT_L(0); MMA(0, 0, At, B0); BAR;
      LDB(B1, 1, 1); WAIT_V(0); BAR; WAIT_L(0); MMA(0, 1, At, B1); BAR;
      LDA(At, 1, 1); BAR; WAIT_L(0); MMA(1, 0, At, B0); MMA(1, 1, At, B1); BAR; }
    if (wr == 0) BAR;
#undef SA
#undef SB
#undef STAGE
#undef LDA
#undef LDB
#undef MMA
#undef WAIT_V
#undef WAIT_L
#undef BAR
#undef SCHED
    __syncthreads();
    epi(acc, lds, m0, n0, opaque_tid(g.wv));
    __syncthreads();
}
DI void epi8_stage_rm(const f32x4 (&acc)[2][2][4][2], char* img, int tid, const float* rinv) {
    const int wid = tid >> 6, lane = tid & 63, wr = wid >> 2, wc = wid & 3, fr = lane & 15, fq = lane >> 4;
#pragma unroll
    for (int ai = 0; ai < 2; ++ai)
#pragma unroll
        for (int bj = 0; bj < 2; ++bj)
#pragma unroll
            for (int m = 0; m < 4; ++m)
#pragma unroll
                for (int n = 0; n < 2; ++n) {
                    const int row = ai * 128 + wr * 64 + m * 16 + fr, col = bj * 128 + wc * 32 + n * 16 + fq * 4;
                    const f32x4 a = acc[ai][bj][m][n] * rinv[row];
                    u32x2 v; v[0] = pk2(a[0], a[1]); v[1] = pk2(a[2], a[3]);
                    *(u32x2*)(img + img32(row, col)) = v;
                }
}
DI void epi8_stage_vt(const f32x4 (&acc)[2][2][4][2], char* img, int tid, const float* rinv) {
    const int wid = tid >> 6, lane = tid & 63, wr = wid >> 2, wc = wid & 3, fr = lane & 15, fq = lane >> 4;
#pragma unroll
    for (int ai = 0; ai < 2; ++ai)
#pragma unroll
        for (int bj = 0; bj < 2; ++bj)
#pragma unroll
            for (int m = 0; m < 4; ++m)
#pragma unroll
                for (int n = 0; n < 2; ++n) {
                    const int row = ai * 128 + wr * 64 + m * 16 + fr, col = bj * 128 + wc * 32 + n * 16 + fq * 4;
                    const f32x4 a = acc[ai][bj][m][n] * rinv[row];
#pragma unroll
                    for (int j = 0; j < 4; ++j) *(bf16_t*)(img + img32(col + j, row)) = (bf16_t)(pk2(a[j], 0.f) & 0xffffu);
                }
}

DI u32x4 kside_chunk(const char* lds, int row, int chbase, int c, int kind, int t, const float* akn, const float2* tab) {
    const char* rp = lds + row * 512;
    const int sw = row & 31;
    float v[8], pv[8];
    const int pc = (kind == 2) ? (c ^ 4) : (c ^ 2);
    unpack8(*(const u32x4*)(rp + (((chbase + c) ^ sw) << 4)), v);
    unpack8(*(const u32x4*)(rp + (((chbase + pc) ^ sw) << 4)), pv);
    if (kind == 1) {
        float ss = 0.f;
#pragma unroll
        for (int cc = 0; cc < 8; ++cc) {
            float w[8]; unpack8(*(const u32x4*)(rp + (((chbase + cc) ^ sw) << 4)), w);
#pragma unroll
            for (int j = 0; j < 8; ++j) ss += w[j] * w[j];
        }
        const float rinv = rsqrtf(ss * (1.0f / 64.0f) + EPS);
#pragma unroll
        for (int j = 0; j < 8; ++j) { v[j] *= rinv * akn[c * 8 + j]; pv[j] *= rinv * akn[pc * 8 + j]; }
    }
    int tidx; bool first;
    if (kind == 1) { const int pos = (c < 4) ? (t >> 6) : (t & 63); tidx = pos * 16 + (c & 1) * 8; first = !(c & 2); }
    else if (kind == 2) { tidx = T64_OFF + t * 32 + (c & 3) * 8; first = (c < 4); }
    else { tidx = t * 16 + (c & 1) * 8; first = !(c & 2); }
    float o[8];
#pragma unroll
    for (int j = 0; j < 8; ++j) { const float2 cs = tab[tidx + j]; o[j] = v[j] * cs.x + (first ? -pv[j] : pv[j]) * cs.y; }
    return pack8(o);
}

struct EpiZ {
    bf16_t *z, *vtA, *vtB; const float* akn; const float2* tab; const float* psum;
    DI void operator()(const f32x4 (&acc)[2][2][4][2], char* lds, int m0, int n0, int tid) const {
        float* rl = (float*)(lds + LDS_RINV);
        if (tid < 256) {
            float rv = 1.0f;
            if (psum) {
                const float4* pp = (const float4*)(psum + (long)(m0 + tid) * 8);
                const float4 p0 = pp[0], p1 = pp[1];
                rv = rsqrtf(((p0.x + p0.y) + (p0.z + p0.w) + (p1.x + p1.y) + (p1.z + p1.w)) * (1.0f / 1024.0f) + EPS);
            }
            rl[tid] = rv;
        }
        __syncthreads();
        if (n0 == 0) {
            epi8_stage_vt(acc, lds, tid, rl);
            __syncthreads();
            const int b = m0 >> 11, t0 = m0 & 2047;
#pragma unroll
            for (int k = 0; k < 16; ++k) {
                const int idx = tid + NT * k, n = idx >> 5, ch = idx & 31;
                const u32x4 v = *(const u32x4*)(lds + n * 512 + ((ch ^ (n & 31)) << 4));
                bf16_t* vt = (n < 128) ? vtA : vtB;
                *(u32x4*)(vt + (long)(b * 128 + (n & 127)) * VTS + t0 + ch * 8) = v;
            }
        } else {
            epi8_stage_rm(acc, lds, tid, rl);
            __syncthreads();
            const int ch_limit = (IN_COLS - n0) >> 3;
            const int kind = (n0 == 512) ? 1 : (n0 == 1536) ? 2 : (n0 == 2304) ? 3 : 0;
            const int klo = (kind == 1) ? 16 : (kind == 3) ? 8 : 0, khi = (kind == 1) ? 32 : (kind == 2) ? 16 : (kind == 3) ? 12 : 0;
#pragma unroll
            for (int k = 0; k < 16; ++k) {
                const int idx = tid + NT * k, row = idx >> 5, ch = idx & 31;
                const u32x4 v = *(const u32x4*)(lds + row * 512 + ((ch ^ (row & 31)) << 4));
                if (ch < ch_limit && !(ch >= klo && ch < khi)) *(u32x4*)(z + (long)(m0 + row) * IN_COLS + n0 + ch * 8) = v;
            }
            if (kind) {
                const int lg = (kind == 3) ? 2 : 4;
                const int per = (256 << lg) / NT;
#pragma unroll 1
                for (int i0 = 0; i0 < per; i0 += 4) {
                    u32x4 o[4]; int rr[4], cc[4];
#pragma unroll
                    for (int u = 0; u < 4; ++u) {
                        const int e = tid + NT * (i0 + u), row = e >> lg, hc = e & ((1 << lg) - 1);
                        rr[u] = row; cc[u] = klo + hc;
                        if (i0 + u < per) o[u] = kside_chunk(lds, row, (kind == 3) ? klo : klo + (hc & ~7), (kind == 3) ? hc : (hc & 7), kind, (m0 + row) & 2047, akn, tab);
                    }
#pragma unroll
                    for (int u = 0; u < 4; ++u)
                        if (i0 + u < per) *(u32x4*)(z + (long)(m0 + rr[u]) * IN_COLS + n0 + cc[u] * 8) = o[u];
                }
            }
        }
    }
};
struct EpiQC {
    bf16_t* qc;
    DI void operator()(const f32x16 (&acc)[4][2], char* lds, int m0, int n0, int tid) const {
        const int wn = (tid >> 6) & 3;
        epi_stage_rm<true>(acc, lds, tid, wn * 64, (const float*)(lds + LDS_RINV));
        __syncthreads();
        const int ch_limit = (384 - n0) >> 3;
#pragma unroll
        for (int k = 0; k < 16; ++k) {
            const int idx = tid + NT * k, row = idx >> 5, ch = idx & 31;
            const u32x4 v = *(const u32x4*)(lds + row * 512 + ((ch ^ (row & 31)) << 4));
            if (ch < ch_limit) *(u32x4*)(qc + (long)(m0 + row) * 384 + n0 + ch * 8) = v;
        }
    }
};
struct EpiKV {
    bf16_t *kc, *vtC;
    DI void operator()(const f32x16 (&acc)[4][2], char* lds, int m0, int n0, int tid) const {
        const int wn = (tid >> 6) & 3, hl = wn >> 1, head0 = (n0 >> 8) * 2;
        if ((wn & 1) == 0) epi_stage_rm<false>(acc, lds, tid, hl * 64, (const float*)(lds + LDS_RINV));
        else epi_stage_vt(acc, lds + 65536, tid, hl * 64, (const float*)(lds + LDS_RINV));
        __syncthreads();
        const int b = m0 >> 11, t0 = m0 & 2047;
#pragma unroll
        for (int k = 0; k < 8; ++k) {
            const int idx = tid + NT * k, row = idx >> 4, ch = idx & 15;
            const u32x4 v = *(const u32x4*)(lds + row * 256 + ((ch ^ (row & 15)) << 4));
            *(u32x4*)(kc + (long)(m0 + row) * KCS + (head0 + (ch >> 3)) * 64 + (ch & 7) * 8) = v;
        }
#pragma unroll
        for (int k = 0; k < 8; ++k) {
            const int idx = tid + NT * k, n = idx >> 5, ch = idx & 31;
            const u32x4 v = *(const u32x4*)(lds + 65536 + n * 512 + ((ch ^ (n & 31)) << 4));
            *(u32x4*)(vtC + (long)((b * 4 + head0 + (n >> 6)) * 64 + (n & 63)) * VTS + t0 + ch * 8) = v;
        }
    }
};
struct EpiOut {
    const float* xin; float* out; bf16_t* xb2; float* psum;
    DI void operator()(const f32x4 (&acc)[2][2][4][2], char* lds, int m0, int n0, int tid) const {
        const int wid = tid >> 6, lane = tid & 63, wr = wid >> 2, wc = wid & 3, fr = lane & 15, fq = lane >> 4;
#pragma unroll
        for (int p = 0; p < 2; ++p) {
#pragma unroll
            for (int ai = 0; ai < 2; ++ai)
#pragma unroll
                for (int m = 0; m < 4; ++m)
#pragma unroll
                    for (int n = 0; n < 2; ++n) {
                        const int row = ai * 128 + wr * 64 + m * 16 + fr, ch = (wc * 32 + n * 16 + fq * 4) >> 2;
                        const f32x4 a = acc[ai][p][m][n];
                        float4 v; v.x = a[0]; v.y = a[1]; v.z = a[2]; v.w = a[3];
                        *(float4*)(lds + row * 512 + ((ch ^ (row & 31)) << 4)) = v;
                    }
            __syncthreads();
#pragma unroll 1
            for (int k2 = 0; k2 < 4; ++k2) {
                float4 xv[4];
#pragma unroll
                for (int k = 0; k < 4; ++k) { const int idx = tid + NT * (k2 * 4 + k), row = idx >> 5, ch = idx & 31; xv[k] = ld_nt(xin + (long)(m0 + row) * 1024 + n0 + p * 128 + ch * 4); }
#pragma unroll
                for (int k = 0; k < 4; ++k) {
                    const int idx = tid + NT * (k2 * 4 + k), row = idx >> 5, ch = idx & 31;
                    const float4 v = *(const float4*)(lds + row * 512 + ((ch ^ (row & 31)) << 4));
                    float4 o; o.x = xv[k].x + v.x; o.y = xv[k].y + v.y; o.z = xv[k].z + v.z; o.w = xv[k].w + v.w;
                    if (xb2) st_nt(out + (long)(m0 + row) * 1024 + n0 + p * 128 + ch * 4, o);
                    else *(float4*)(out + (long)(m0 + row) * 1024 + n0 + p * 128 + ch * 4) = o;
                    if (xb2) {
                        u32x2 ob; ob[0] = pk2(o.x, o.y); ob[1] = pk2(o.z, o.w);
                        *(u32x2*)(xb2 + (long)(m0 + row) * LDX + n0 + p * 128 + ch * 4) = ob;
                        float ss = o.x * o.x + o.y * o.y + o.z * o.z + o.w * o.w;
                        ss += __shfl_xor(ss, 1); ss += __shfl_xor(ss, 2); ss += __shfl_xor(ss, 4); ss += __shfl_xor(ss, 8); ss += __shfl_xor(ss, 16);
                        if (ch == 0) psum[(long)(m0 + row) * 8 + (n0 >> 8) * 2 + p] = ss;
                    }
                }
            }
            __syncthreads();
        }
    }
};

DI void phase_kprep(const Params& P, int l) {
    const int tid = opaque_tid(P.wv), lane = tid & 63;
    const int gw = blockIdx.x * NWV + (tid >> 6), nw = gridDim.x * NWV;
    constexpr int TK = 4;
    const int grp = (lane < 16) ? 0 : (lane < 32) ? 1 : 2;
    const int c = (grp == 2) ? (lane & 3) : (lane & 7);
    const int off1 = (grp == 0) ? OFF_AK + lane * 8 : (grp == 1) ? OFF_BK + (lane - 16) * 8 : OFF_CKR + (lane & 3) * 8;
    const int hl = lane & 31;
    const bool lo = lane < 32;
    const bool valid2 = lo ? (hl < 24) : (hl < 16);
    const int off2 = (lo ? OFF_CQ : OFF_CKV) + (valid2 ? hl : 0) * 8;
    const bool first = (grp == 1) ? (c < 4) : !(c & 2);
    float kn[8];
#pragma unroll
    for (int j = 0; j < 8; ++j) kn[j] = (grp == 0) ? P.a_kn[l * 64 + c * 8 + j] : 1.0f;
    for (int tok0 = gw * TK; tok0 < NTOK; tok0 += nw * TK) {
        u32x4 raw1[TK], raw2[TK];
        float2 cs[TK][8];
#pragma unroll
        for (int u = 0; u < TK; ++u) {
            const int tok = tok0 + u, t = tok & 2047;
            const bf16_t* zr = P.z() + (long)tok * IN_COLS;
            raw1[u] = *(const u32x4*)(zr + off1);
            raw2[u] = *(const u32x4*)(zr + off2);
            int tidx;
            if (grp == 0) { const int pos = (c < 4) ? (t >> 6) : (t & 63); tidx = pos * 16 + (c & 1) * 8; }
            else if (grp == 1) tidx = T64_OFF + t * 32 + (c & 3) * 8;
            else tidx = t * 16 + (c & 1) * 8;
            const float2* tb = P.t32() + tidx;
#pragma unroll
            for (int j = 0; j < 8; ++j) cs[u][j] = tb[j];
        }
#pragma unroll
        for (int u = 0; u < TK; ++u) {
            bf16_t* zr = P.z() + (long)(tok0 + u) * IN_COLS;
            {
                float v[8]; unpack8(raw1[u], v);
                float ss = 0.f;
#pragma unroll
                for (int j = 0; j < 8; ++j) ss += v[j] * v[j];
                ss += __shfl_xor(ss, 1); ss += __shfl_xor(ss, 2); ss += __shfl_xor(ss, 4);
                if (grp == 0) {
                    const float rinv = rsqrtf(ss * (1.0f / 64.0f) + EPS);
#pragma unroll
                    for (int j = 0; j < 8; ++j) v[j] = v[j] * rinv * kn[j];
                }
                float o[8];
#pragma unroll
                for (int j = 0; j < 8; ++j) {
                    const float p2 = __shfl_xor(v[j], 2), p4 = __shfl_xor(v[j], 4);
                    const float pv = (grp == 1) ? p4 : p2;
                    o[j] = v[j] * cs[u][j].x + (first ? -pv : pv) * cs[u][j].y;
                }
                if (lane < 36) *(u32x4*)(zr + off1) = pack8(o);
            }
            {
                float v[8]; unpack8(raw2[u], v);
                float ss = 0.f;
                if (valid2) {
#pragma unroll
                    for (int j = 0; j < 8; ++j) ss += v[j] * v[j];
                }
                ss += __shfl_xor(ss, 1); ss += __shfl_xor(ss, 2); ss += __shfl_xor(ss, 4); ss += __shfl_xor(ss, 8); ss += __shfl_xor(ss, 16);
                const float rinv = rsqrtf(ss * (lo ? (1.0f / 192.0f) : (1.0f / 128.0f)) + EPS);
#pragma unroll
                for (int j = 0; j < 8; ++j) v[j] *= rinv;
                if (valid2) *(u32x4*)(zr + off2) = pack8(v);
            }
        }
    }
}

template <int TYPE, int NQT>
DI void attn_item(const Params& P, int l, int b, int kvh, int headA, int qbA, int headB, int qbB, char* lds) {
    constexpr int NS = (TYPE == 2) ? 6 : 4;
    const int tid = opaque_tid(P.wv), lane = tid & 63, wid = P.wv, r = lane & 31, h = lane >> 5;
    const int head = (wid >> 2) ? headB : headA, qb = (wid >> 2) ? qbB : qbA;
    const int q0 = qb * (128 * NQT) + (wid & 3) * (32 * NQT);
    const float sc = ((TYPE == 2) ? 0.10206207261596577f : 0.125f) * LOG2E;
    int skipmax = 0;
    if (TYPE == 0) {
        float wq = fabsf(P.a_qn[l * 64 + lane]), wk = fabsf(P.a_kn[l * 64 + lane]);
#pragma unroll
        for (int o = 32; o >= 1; o >>= 1) { wq = fmaxf(wq, __shfl_xor(wq, o)); wk = fmaxf(wk, __shfl_xor(wk, o)); }
        skipmax = __builtin_amdgcn_readfirstlane((8.0f * wq * wk * LOG2E * 1.05f < 30.0f) ? 1 : 0);
    }

    bf16x8 qf[NQT][NS];
#pragma unroll
    for (int qt = 0; qt < NQT; ++qt) {
        const int tq = q0 + qt * 32 + r;
        const long tok = (long)b * SEQ + tq;
        const bf16_t* src = (TYPE == 0) ? P.z() + tok * IN_COLS + OFF_AQ + head * 64 : (TYPE == 1) ? P.z() + tok * IN_COLS + OFF_BQ + head * 64 : P.qc() + tok * 384 + head * 96;
        float qv[NS][8];
#pragma unroll
        for (int s = 0; s < NS; ++s) { const u32x4 raw = *(const u32x4*)(src + 16 * s + 8 * h); unpack8(raw, qv[s]); }
        if (TYPE == 0) {
            float ss = 0.f;
#pragma unroll
            for (int s = 0; s < 4; ++s)
#pragma unroll
                for (int j = 0; j < 8; ++j) ss += qv[s][j] * qv[s][j];
            ss = xhalf_sum(ss);
            const float rinv = rsqrtf(ss * (1.0f / 64.0f) + EPS);
#pragma unroll
            for (int s = 0; s < 4; ++s)
#pragma unroll
                for (int j = 0; j < 8; ++j) qv[s][j] *= rinv * P.a_qn[l * 64 + 16 * s + 8 * h + j];
            const float2* tr = P.t32() + (tq >> 6) * 16 + 8 * h;
            const float2* tc = P.t32() + (tq & 63) * 16 + 8 * h;
#pragma unroll
            for (int j = 0; j < 8; ++j) {
                const float2 a = tr[j], c2 = tc[j];
                const float x0 = qv[0][j], x1 = qv[1][j], y0 = qv[2][j], y1 = qv[3][j];
                qv[0][j] = x0 * a.x - x1 * a.y; qv[1][j] = x1 * a.x + x0 * a.y;
                qv[2][j] = y0 * c2.x - y1 * c2.y; qv[3][j] = y1 * c2.x + y0 * c2.y;
            }
        } else if (TYPE == 1) {
            const float2* t0 = P.t32() + T64_OFF + tq * 32 + 8 * h;
#pragma unroll
            for (int j = 0; j < 8; ++j) {
                const float2 a = t0[j], c2 = t0[16 + j];
                const float x0 = qv[0][j], x1 = qv[2][j], y0 = qv[1][j], y1 = qv[3][j];
                qv[0][j] = x0 * a.x - x1 * a.y; qv[2][j] = x1 * a.x + x0 * a.y;
                qv[1][j] = y0 * c2.x - y1 * c2.y; qv[3][j] = y1 * c2.x + y0 * c2.y;
            }
        } else {
            const float2* t0 = P.t32() + tq * 16 + 8 * h;
#pragma unroll
            for (int j = 0; j < 8; ++j) {
                const float2 a = t0[j];
                const float x0 = qv[NS - 2][j], x1 = qv[NS - 1][j];
                qv[NS - 2][j] = x0 * a.x - x1 * a.y; qv[NS - 1][j] = x1 * a.x + x0 * a.y;
            }
        }
#pragma unroll
        for (int s = 0; s < NS; ++s) {
            float tmp[8];
#pragma unroll
            for (int j = 0; j < 8; ++j) tmp[j] = qv[s][j] * sc;
            qf[qt][s] = __builtin_bit_cast(bf16x8, pack8(tmp));
        }
    }

    const bf16_t* kbase; long kstride; const bf16_t* vbase; const bf16_t* krbase = nullptr;
    if (TYPE == 0) { kbase = P.z() + (long)b * SEQ * IN_COLS + OFF_AK + kvh * 64; kstride = IN_COLS; vbase = P.vtA() + (long)((b * 2 + kvh) * 64) * VTS; }
    else if (TYPE == 1) { kbase = P.z() + (long)b * SEQ * IN_COLS + OFF_BK + kvh * 64; kstride = IN_COLS; vbase = P.vtB() + (long)((b * 2 + kvh) * 64) * VTS; }
    else { kbase = P.kc() + (long)b * SEQ * KCS + head * 64; kstride = KCS; vbase = P.vtC() + (long)((b * 4 + head) * 64) * VTS; krbase = P.z() + (long)b * SEQ * IN_COLS + OFF_CKR; }
    int kt_lo = 0, kt_hi = 32;
    if (TYPE == 1) {
        kt_lo = qbA * (2 * NQT) - 2; if (kt_lo < 0) kt_lo = 0; kt_hi = qbB * (2 * NQT) + 2 * NQT + 2; if (kt_hi > 32) kt_hi = 32;
    }

    const bf16_t* krp = (TYPE == 2) ? krbase : nullptr;
    constexpr int BUF = (TYPE == 2) ? 20480 : 16384;
#define ATT_STAGE(buf_, kt_)                                                                             \
    {                                                                                                    \
        char* ls_ = lds + (buf_) * BUF;                                                                  \
        glds_rows128<64>(kbase + (long)((kt_) * 64) * kstride, kstride, ls_, tid);                       \
        glds_rows128<64>(vbase + (kt_) * 64, VTS, ls_ + 8192, tid);                                      \
        if (TYPE == 2) glds_rows64(krp + (long)((kt_) * 64) * IN_COLS, IN_COLS, ls_ + 16384, tid);       \
    }

    const int pr = (r & 0x13) | ((r & 4) << 1) | ((r & 8) >> 1);
    int koff[NS];
#pragma unroll
    for (int s = 0; s < NS; ++s) {
        if (s < 4) koff[s] = pr * 128 + (((2 * s + h) ^ ((pr >> 1) & 7)) << 4);
        else koff[s] = 16384 + pr * 64 + (((2 * (s - 4) + h) ^ ((pr >> 2) & 3)) << 4);
    }
    int voff[2][2];
#pragma unroll
    for (int c = 0; c < 2; ++c)
#pragma unroll
        for (int s2 = 0; s2 < 2; ++s2) voff[c][s2] = 8192 + r * 128 + (((4 * c + 2 * s2 + h) ^ ((r >> 1) & 7)) << 4);

    f32x16 O[NQT][2];
#pragma unroll
    for (int a = 0; a < NQT; ++a)
#pragma unroll
        for (int d = 0; d < 2; ++d)
#pragma unroll
            for (int i = 0; i < 16; ++i) O[a][d][i] = 0.f;
    constexpr bool MT = true;
    constexpr bool MSH = (TYPE == 2);
    constexpr int NM = MSH ? 1 : NQT;
    float m[NQT], lsum[NQT];
#pragma unroll
    for (int a = 0; a < NQT; ++a) {
        if (TYPE == 1) { m[a] = P.b_sink[l * 6 + head] * LOG2E; lsum[a] = (h == 0) ? 1.f : 0.f; }
        else if (MT) { m[a] = 0.f; lsum[a] = 0.f; }
        else { m[a] = -INFINITY; lsum[a] = 0.f; }
    }
    f32x16 Mneg[NM];
    if (MT) {
#pragma unroll
        for (int a = 0; a < NM; ++a)
#pragma unroll
            for (int i = 0; i < 16; ++i) Mneg[a][i] = -m[a];
    }

    constexpr bool PAIR = (TYPE != 2);
    ATT_STAGE(0, kt_lo);
    if (kt_lo + 1 < kt_hi) ATT_STAGE(1, kt_lo + 1);
    int cur = 0, nx2 = 2;
    for (int kt = kt_lo; kt < kt_hi; ++kt) {
        const char* lb;
        if (PAIR) {
            const int it = kt - kt_lo;
            if ((it & 1) == 0) {
                asm volatile("s_waitcnt vmcnt(0)" ::: "memory");
                __builtin_amdgcn_s_barrier();
                asm volatile("" ::: "memory");
                if (kt + 2 < kt_hi) { ATT_STAGE((it + 2) & 3, kt + 2); if (kt + 3 < kt_hi) ATT_STAGE((it + 3) & 3, kt + 3); }
            }
            lb = lds + (it & 3) * BUF;
        } else {
            if (kt + 1 < kt_hi) { if (wid < 4) asm volatile("s_waitcnt vmcnt(3)" ::: "memory"); else asm volatile("s_waitcnt vmcnt(2)" ::: "memory"); }
            else asm volatile("s_waitcnt vmcnt(0)" ::: "memory");
            __builtin_amdgcn_s_barrier();
            asm volatile("" ::: "memory");
            if (kt + 2 < kt_hi) ATT_STAGE(nx2, kt + 2);
            lb = lds + cur * BUF;
            cur = (cur == 2) ? 0 : cur + 1;
            nx2 = (nx2 == 2) ? 0 : nx2 + 1;
        }
        bool active = true;
        if (TYPE == 1) active = (kt * 64 + 63 >= q0 - 128) && (kt * 64 <= q0 + 32 * NQT - 1 + 128);
#pragma unroll
        for (int c = 0; c < 2; ++c) {
            if (active) {
#pragma unroll
                for (int qt = 0; qt < NQT; ++qt) {
                    bool need_mask = false;
                    if (TYPE == 1) {
                        const int qlo = q0 + qt * 32, klo = kt * 64 + c * 32;
                        if (klo - (qlo + 31) > 128 || qlo - (klo + 31) > 128) continue;
                        need_mask = (klo + 31 - qlo > 128) || (qlo + 31 - klo > 128);
                    }
                    f32x16 S;
                    if (MT) S = Mneg[MSH ? 0 : qt];
                    else {
#pragma unroll
                        for (int i = 0; i < 16; ++i) S[i] = 0.f;
                    }
#pragma unroll
                    for (int s = 0; s < NS; ++s) {
                        const bf16x8 kf = *(const bf16x8*)(lb + koff[s] + c * ((s < 4) ? 4096 : 2048));
                        S = MFMA32(kf, qf[qt][s], S);
                    }
                    if (TYPE == 1 && need_mask) {
                        const int qpos = q0 + qt * 32 + r;
                        const int kb0 = kt * 64 + c * 32 + 8 * h;
#pragma unroll
                        for (int i = 0; i < 16; ++i) {
                            const int key = kb0 + (i & 3) + 4 * ((i >> 2) & 1) + 16 * (i >> 3);
                            const int d = qpos - key;
                            if (d > 128 || d < -128) S[i] = -1e30f;
                        }
                    }
                    float mx = 0.f;
                    if (TYPE != 0 || !skipmax) {
                        mx = S[0];
#pragma unroll
                        for (int i = 1; i < 16; ++i) mx = fmaxf(mx, S[i]);
                        mx = xhalf_max(mx);
                    }
                    if (MT) {
                        if ((TYPE != 0 || !skipmax) && __builtin_amdgcn_ballot_w64(mx > 6.0f) != 0) {
                            const float dlt = fmaxf(mx, 0.f);
                            const float alpha = __builtin_amdgcn_exp2f(-dlt);
                            if (MSH) {
                                m[0] += dlt;
#pragma unroll
                                for (int a = 0; a < NQT; ++a) {
                                    lsum[a] *= alpha;
#pragma unroll
                                    for (int d = 0; d < 2; ++d)
#pragma unroll
                                        for (int i = 0; i < 16; ++i) O[a][d][i] *= alpha;
                                }
#pragma unroll
                                for (int i = 0; i < 16; ++i) { S[i] -= dlt; Mneg[0][i] = -m[0]; }
                            } else {
                                m[qt] += dlt;
                                lsum[qt] *= alpha;
#pragma unroll
                                for (int d = 0; d < 2; ++d)
#pragma unroll
                                    for (int i = 0; i < 16; ++i) O[qt][d][i] *= alpha;
#pragma unroll
                                for (int i = 0; i < 16; ++i) { S[i] -= dlt; Mneg[qt][i] = -m[qt]; }
                            }
                        }
                    } else if (__builtin_amdgcn_ballot_w64(mx - m[qt] > 6.0f) != 0) {
                        const float mnew = fmaxf(m[qt], mx);
                        const float alpha = __builtin_amdgcn_exp2f(m[qt] - mnew);
                        m[qt] = mnew;
                        lsum[qt] *= alpha;
#pragma unroll
                        for (int d = 0; d < 2; ++d)
#pragma unroll
                            for (int i = 0; i < 16; ++i) O[qt][d][i] *= alpha;
                    }
                    const float mcur = MT ? 0.f : m[qt];
                    float rs = 0.f;
#pragma unroll
                    for (int i = 0; i < 16; ++i) { const float p = __builtin_amdgcn_exp2f(MT ? S[i] : S[i] - mcur); S[i] = p; rs += p; }
                    lsum[qt] += rs;
#pragma unroll
                    for (int s2 = 0; s2 < 2; ++s2) {
                        u32x4 pp;
#pragma unroll
                        for (int k = 0; k < 4; ++k) pp[k] = pk2(S[8 * s2 + 2 * k], S[8 * s2 + 2 * k + 1]);
                        const bf16x8 pf = __builtin_bit_cast(bf16x8, pp);
#pragma unroll
                        for (int dvt = 0; dvt < 2; ++dvt) {
                            const bf16x8 vf = *(const bf16x8*)(lb + voff[c][s2] + dvt * 4096);
                            O[qt][dvt] = MFMA32(vf, pf, O[qt][dvt]);
                        }
                    }
                }
            }
        }
    }
    __syncthreads();

    bf16_t* og = P.xb();
    {
        const int tid2 = opaque_tid(P.wv), r2 = tid2 & 31, h2 = (tid2 >> 5) & 1;
        const int head = (tid2 >> 8) ? headB : headA, qb = (tid2 >> 8) ? qbB : qbA;
        const int q02 = qb * (128 * NQT) + ((tid2 >> 6) & 3) * (32 * NQT);
#pragma unroll
        for (int qt = 0; qt < NQT; ++qt) {
            const float lt = xhalf_sum(lsum[qt]);
            const float inv = __builtin_amdgcn_rcpf(lt);
            const long tok = (long)b * SEQ + q02 + qt * 32 + r2;
            const bf16_t* gp = P.z() + tok * IN_COLS + ((TYPE == 0) ? OFF_AG : (TYPE == 1) ? OFF_BG : OFF_CG) + head * 64;
            bf16_t* op = og + tok * LDX + ((TYPE == 0) ? 0 : (TYPE == 1) ? 384 : 768) + head * 64;
            u32x2 graw[2][4];
#pragma unroll
            for (int dvt = 0; dvt < 2; ++dvt)
#pragma unroll
                for (int g4 = 0; g4 < 4; ++g4) graw[dvt][g4] = *(const u32x2*)(gp + dvt * 32 + 8 * g4 + 4 * h2);
#pragma unroll
            for (int dvt = 0; dvt < 2; ++dvt)
#pragma unroll
                for (int g4 = 0; g4 < 4; ++g4) {
                    const int dv = dvt * 32 + 8 * g4 + 4 * h2;
                    const float gv0 = bflo(graw[dvt][g4][0]), gv1 = bfhi(graw[dvt][g4][0]), gv2 = bflo(graw[dvt][g4][1]), gv3 = bfhi(graw[dvt][g4][1]);
                    const float o0 = O[qt][dvt][4 * g4 + 0] * inv * (gv0 * __builtin_amdgcn_rcpf(1.0f + __expf(-gv0)));
                    const float o1 = O[qt][dvt][4 * g4 + 1] * inv * (gv1 * __builtin_amdgcn_rcpf(1.0f + __expf(-gv1)));
                    const float o2 = O[qt][dvt][4 * g4 + 2] * inv * (gv2 * __builtin_amdgcn_rcpf(1.0f + __expf(-gv2)));
                    const float o3 = O[qt][dvt][4 * g4 + 3] * inv * (gv3 * __builtin_amdgcn_rcpf(1.0f + __expf(-gv3)));
                    u32x2 o; o[0] = pk2(o0, o1); o[1] = pk2(o2, o3);
                    *(u32x2*)(op + dv) = o;
                }
        }
    }
#undef ATT_STAGE
}

DI void phase_attn(const Params& P, int l, char* lds, volatile unsigned* sh_idx, int rep) {
    const int x = blockIdx.x & 7;
    unsigned* ctr = P.bar() + XCD_BAR_WORDS + (l * 8 + x) * 16 + rep * 8;
    for (;;) {
        __syncthreads();
        if (opaque_tid(P.wv) == 0) *sh_idx = atomicAdd(ctr, 1u);
        __syncthreads();
        const int q = (int)__builtin_amdgcn_readfirstlane(*sh_idx);
        if (q >= 128) break;
        if (q < 32) { const int b = 2 * x + (q >> 4), v = q & 15, head = v & 3, qbp = v >> 2; attn_item<2, 2>(P, l, b, 0, head, 2 * qbp, head, 2 * qbp + 1, lds); }
        else {
            const int u = (q < 80) ? q - 32 : q - 80, b = 2 * x + u / 24, w = u % 24, kvh = w / 12, w2 = w % 12, qbp = w2 / 3, j = w2 % 3;
            const int hA = kvh * 3 + ((j == 1) ? 2 : 0), hB = kvh * 3 + ((j == 1) ? 2 : 1);
            const int qA = 2 * qbp + ((j == 2) ? 1 : 0), qB = 2 * qbp + ((j == 0) ? 0 : 1);
            if (q < 80) attn_item<0, 2>(P, l, b, kvh, hA, qA, hB, qB, lds);
            else attn_item<1, 2>(P, l, b, kvh, hA, qA, hB, qB, lds);
        }
    }
}

constexpr int N_PHASES = 13;
DI void run_phase(const Params& P, int ph, char* lds, volatile unsigned* sh_idx, int rep = 0) {
    if (ph == 0) { phase_prep(P); phase_norm<false>(P.x, P.xb(), nullptr, nullptr, P.wv); return; }
    if (ph == 12) { phase_norm<true>(P.out, nullptr, P.out, P.final_g, P.wv); return; }
    const int l = (ph >= 6) ? 1 : 0;
    const int sub = ph - 6 * l;
    if (sub == 0) return;
    if (sub == 1) {
        GemmArgs g{(l == 0) ? P.xb() : P.xb2(), LDX, P.winT() + (long)l * IN_PAD * LDW, LDW, 1024, P.wv};
        EpiZ epi{P.z(), P.vtA(), P.vtB(), P.a_kn + l * 64, P.t32(), (l == 0) ? nullptr : P.psum()};
        for_items(128 * 11, [&](int t) { gemm_tile8(g, (t / 11) * 256, (t % 11) * 256, lds, epi); });
        return;
    }
    if (sub == 2) return;
    if (sub == 3) {
        GemmArgs gq{P.z() + OFF_CQ, IN_COLS, P.wuqT() + (long)l * 512 * 192, 192, 192, P.wv};
        GemmArgs gk{P.z() + OFF_CKV, IN_COLS, P.wukvT() + (long)l * 512 * 128, 128, 128, P.wv};
        EpiQC eq{P.qc()};
        EpiKV ek{P.kc(), P.vtC()};
        for_items(128 * 4, [&](int t) {
            const int mt = t >> 2, n = t & 3;
            {
                const int tid = opaque_tid(P.wv), row = tid >> 1, half = tid & 1, ncols = (n < 2) ? 192 : 128;
                const bf16_t* p = P.z() + (long)(mt * 256 + row) * IN_COLS + ((n < 2) ? OFF_CQ : OFF_CKV) + half * (ncols >> 1);
                float ss = 0.f;
                for (int c = 0; c < (ncols >> 4); ++c) {
                    float w[8]; unpack8(*(const u32x4*)(p + c * 8), w);
#pragma unroll
                    for (int j = 0; j < 8; ++j) ss += w[j] * w[j];
                }
                ss += __shfl_xor(ss, 1);
                if (half == 0) ((float*)(lds + LDS_RINV))[row] = rsqrtf(ss / (float)ncols + EPS);
            }
            if (n < 2) gemm_tile(gq, mt * 256, n * 256, lds, eq);
            else gemm_tile(gk, mt * 256, (n - 2) * 256, lds, ek);
        });
        return;
    }
    if (sub == 4) { phase_attn(P, l, lds, sh_idx, rep); return; }
    if (sub == 5) {
        GemmArgs g{P.xb(), LDX, P.woutT() + (long)l * 1024 * LDW, LDW, 1024, P.wv};
        EpiOut epi{(l == 0) ? P.x : P.out, P.out, (l == 0) ? P.xb2() : nullptr, P.psum()};
        for_items(128 * 4, [&](int t) { gemm_tile8(g, (t >> 2) * 256, (t & 3) * 256, lds, epi); });
        return;
    }
}

template <bool COOP>
__global__ void __launch_bounds__(NT, 2) mega(Params P, int plo, int phi) {
    extern __shared__ __attribute__((aligned(16))) char lds[];
    volatile unsigned* xw = (volatile unsigned*)(lds + LDS_RING);
    volatile unsigned* sh_idx = xw + 2;
    Params Q = P;
    Q.wv = __builtin_amdgcn_readfirstlane((int)threadIdx.x >> 6);
    if (COOP) {
        if (opaque_tid(Q.wv) == 0) { xw[0] = 0u; xw[1] = 0u; xw[2] = 0u; xw[3] = 0u; }
        __syncthreads();
        XcdBarrier xb = xcd_barrier_post(Q.bar(), (volatile LAS unsigned*)(lds + LDS_RING), Q.wv);
        for (int ph = plo; ph < phi; ++ph) {
            if (ph == 2 || ph == 8 || ph == 6) continue;
            run_phase(Q, ph, lds, sh_idx);
            if ((REP_MASK >> ph) & 1) { xcd_barrier(xb); run_phase(Q, ph, lds, sh_idx, 1); }
            if (ph + 1 < phi) {
                if (plo < 0) cg::this_grid().sync();
                xcd_barrier(xb);
            }
        }
    } else {
        for (int ph = plo; ph < phi; ++ph) run_phase(Q, ph, lds, sh_idx);
    }
}

extern "C" void kernel_launch(void* const* d_in, const int* in_sizes, int n_in, void* d_out, int out_size, void* d_ws, size_t ws_size, hipStream_t stream) {
    Params P{};
    P.x = (const float*)d_in[0]; P.norm_g = (const float*)d_in[1]; P.w_in = (const float*)d_in[2]; P.a_qn = (const float*)d_in[3];
    P.a_kn = (const float*)d_in[4]; P.b_sink = (const float*)d_in[5]; P.c_qn = (const float*)d_in[6]; P.c_kvn = (const float*)d_in[7];
    P.c_wuq = (const float*)d_in[8]; P.c_wukv = (const float*)d_in[9]; P.w_out = (const float*)d_in[10]; P.final_g = (const float*)d_in[11];
    P.out = (float*)d_out;
    P.ws = (char*)d_ws;
    if (WS_TOTAL > ws_size) { fprintf(stderr, "workspace too small: need %zu have %zu\n", (size_t)WS_TOTAL, ws_size); return; }

    static int grid_blocks = 0;
    if (!grid_blocks) {
        int dev = 0, cus = 0, per_cu = 0;
        hipGetDevice(&dev);
        hipDeviceGetAttribute(&cus, hipDeviceAttributeMultiprocessorCount, dev);
#if MK_COOP
        hipFuncSetAttribute((const void*)mega<true>, hipFuncAttributeMaxDynamicSharedMemorySize, LDS_BYTES);
        hipOccupancyMaxActiveBlocksPerMultiprocessor(&per_cu, mega<true>, NT, LDS_BYTES);
#else
        hipFuncSetAttribute((const void*)mega<false>, hipFuncAttributeMaxDynamicSharedMemorySize, LDS_BYTES);
        hipOccupancyMaxActiveBlocksPerMultiprocessor(&per_cu, mega<false>, NT, LDS_BYTES);
#endif
        if (per_cu < 1) per_cu = 1;
        if (per_cu > 1) per_cu = 1;
        grid_blocks = cus * per_cu;
    }
#if MK_COOP
    hipMemsetAsync(P.bar(), 0, (XCD_BAR_WORDS + 512) * 4, stream);
    int plo = 0, phi = N_PHASES;
    void* args[] = {&P, &plo, &phi};
    hipError_t e = hipLaunchCooperativeKernel((void*)mega<true>, dim3(grid_blocks), dim3(NT), args, LDS_BYTES, stream);
    if (e != hipSuccess) fprintf(stderr, "cooperative launch failed: %s (grid %d)\n", hipGetErrorString(e), grid_blocks);
#else
    for (int ph = 0; ph < N_PHASES; ++ph) mega<false><<<dim3(grid_blocks), dim3(NT), LDS_BYTES, stream>>>(P, ph, ph + 1);
#endif
}
```

```cpp
#include <hip/hip_runtime.h>
#include <hip/hip_cooperative_groups.h>
#include <stdint.h>
#include <cstdio>
namespace cg = cooperative_groups;

#ifndef REP_MASK
#define REP_MASK 0
#endif
#ifndef MK_COOP
#define MK_COOP 1
#endif

#define DI __device__ __forceinline__
typedef unsigned short bf16_t;
typedef short bf16x8 __attribute__((ext_vector_type(8)));
typedef float f32x16 __attribute__((ext_vector_type(16)));
typedef unsigned u32x4 __attribute__((ext_vector_type(4)));
typedef unsigned u32x2 __attribute__((ext_vector_type(2)));
typedef __bf16 bf2_t __attribute__((ext_vector_type(2)));
typedef float f2_t __attribute__((ext_vector_type(2)));

constexpr int D_MODEL = 1024, SEQ = 2048, NBATCH = 16, NTOK = NBATCH * SEQ;
constexpr int IN_COLS = 2656, IN_PAD = 2816;
constexpr int NT = 512, NWV = 8;
constexpr int LDS_RING = 131072, LDS_RINV = LDS_RING + 16, LDS_BYTES = LDS_RINV + 1024;
constexpr int LDX = 1088, LDW = 1088, VTS = 2112, KCS = 320;
constexpr int OFF_AV = 0, OFF_BV = 128, OFF_AQ = 256, OFF_AK = 640, OFF_AG = 768, OFF_BQ = 1152, OFF_BK = 1536, OFF_BG = 1664,
              OFF_CQ = 2048, OFF_CKV = 2240, OFF_CKR = 2368, OFF_CG = 2400;
constexpr int T64_OFF = 2048 * 16;
constexpr float EPS = 1e-6f;
constexpr float LOG2E = 1.4426950408889634f;

#define XCD_BAR_WORDS 3456
constexpr size_t wsal(size_t b) { return (b + 255) & ~(size_t)255; }
constexpr size_t WS_xb = 0;
constexpr size_t WS_z = WS_xb + wsal((size_t)NTOK * LDX * 2);
constexpr size_t WS_qc = WS_z + wsal((size_t)NTOK * IN_COLS * 2);
constexpr size_t WS_kc = WS_qc + wsal((size_t)NTOK * 384 * 2);
constexpr size_t WS_vtA = WS_kc + wsal((size_t)NTOK * KCS * 2);
constexpr size_t WS_vtB = WS_vtA + wsal((size_t)NBATCH * 2 * 64 * VTS * 2);
constexpr size_t WS_vtC = WS_vtB + wsal((size_t)NBATCH * 2 * 64 * VTS * 2);
constexpr size_t WS_winT = WS_vtC + wsal((size_t)NBATCH * 4 * 64 * VTS * 2);
constexpr size_t WS_woutT = WS_winT + wsal((size_t)2 * IN_PAD * LDW * 2);
constexpr size_t WS_wuqT = WS_woutT + wsal((size_t)2 * 1024 * LDW * 2);
constexpr size_t WS_wukvT = WS_wuqT + wsal((size_t)2 * 512 * 192 * 2);
constexpr size_t WS_t32 = WS_wukvT + wsal((size_t)2 * 512 * 128 * 2);
constexpr size_t WS_bar = WS_t32 + wsal((size_t)2048 * 48 * 8);
constexpr size_t WS_xb2 = WS_bar + wsal((size_t)(XCD_BAR_WORDS + 512) * 4);
constexpr size_t WS_psum = WS_xb2 + wsal((size_t)NTOK * LDX * 2);
constexpr size_t WS_TOTAL = WS_psum + wsal((size_t)NTOK * 8 * 4);
struct Params {
    const float *x, *norm_g, *w_in, *a_qn, *a_kn, *b_sink, *c_qn, *c_kvn, *c_wuq, *c_wukv, *w_out, *final_g;
    float* out;
    char* ws;
    int wv, pad_;
    __host__ __device__ __forceinline__ bf16_t* xb() const { return (bf16_t*)(ws + WS_xb); }
    __host__ __device__ __forceinline__ bf16_t* z() const { return (bf16_t*)(ws + WS_z); }
    __host__ __device__ __forceinline__ bf16_t* qc() const { return (bf16_t*)(ws + WS_qc); }
    __host__ __device__ __forceinline__ bf16_t* kc() const { return (bf16_t*)(ws + WS_kc); }
    __host__ __device__ __forceinline__ bf16_t* vtA() const { return (bf16_t*)(ws + WS_vtA); }
    __host__ __device__ __forceinline__ bf16_t* vtB() const { return (bf16_t*)(ws + WS_vtB); }
    __host__ __device__ __forceinline__ bf16_t* vtC() const { return (bf16_t*)(ws + WS_vtC); }
    __host__ __device__ __forceinline__ bf16_t* winT() const { return (bf16_t*)(ws + WS_winT); }
    __host__ __device__ __forceinline__ bf16_t* woutT() const { return (bf16_t*)(ws + WS_woutT); }
    __host__ __device__ __forceinline__ bf16_t* wuqT() const { return (bf16_t*)(ws + WS_wuqT); }
    __host__ __device__ __forceinline__ bf16_t* wukvT() const { return (bf16_t*)(ws + WS_wukvT); }
    __host__ __device__ __forceinline__ float2* t32() const { return (float2*)(ws + WS_t32); }
    __host__ __device__ __forceinline__ unsigned* bar() const { return (unsigned*)(ws + WS_bar); }
    __host__ __device__ __forceinline__ bf16_t* xb2() const { return (bf16_t*)(ws + WS_xb2); }
    __host__ __device__ __forceinline__ float* psum() const { return (float*)(ws + WS_psum); }
};

typedef float f4v __attribute__((ext_vector_type(4)));
DI float4 ld_nt(const float* p) { const f4v v = __builtin_nontemporal_load((const f4v*)p); float4 o; o.x = v[0]; o.y = v[1]; o.z = v[2]; o.w = v[3]; return o; }
DI void st_nt(float* p, const float4& o) { f4v v; v[0] = o.x; v[1] = o.y; v[2] = o.z; v[3] = o.w; __builtin_nontemporal_store(v, (f4v*)p); }
DI unsigned pk2(float lo, float hi) { f2_t v = {lo, hi}; return __builtin_bit_cast(unsigned, __builtin_convertvector(v, bf2_t)); }
DI float bflo(unsigned u) { return __uint_as_float(u << 16); }
DI float bfhi(unsigned u) { return __uint_as_float(u & 0xffff0000u); }
DI void unpack8(const u32x4& raw, float* v) {
#pragma unroll
    for (int k = 0; k < 4; ++k) { v[2 * k] = bflo(raw[k]); v[2 * k + 1] = bfhi(raw[k]); }
}
DI u32x4 pack8(const float* v) { u32x4 o; o[0] = pk2(v[0], v[1]); o[1] = pk2(v[2], v[3]); o[2] = pk2(v[4], v[5]); o[3] = pk2(v[6], v[7]); return o; }
DI float wave_sum(float v) {
#pragma unroll
    for (int o = 32; o >= 1; o >>= 1) v += __shfl_xor(v, o);
    return v;
}

DI float xhalf_max(float x) { const auto p = __builtin_amdgcn_permlane32_swap(__float_as_uint(x), __float_as_uint(x), false, false); return fmaxf(__uint_as_float(p[0]), __uint_as_float(p[1])); }
DI float xhalf_sum(float x) { const auto p = __builtin_amdgcn_permlane32_swap(__float_as_uint(x), __float_as_uint(x), false, false); return __uint_as_float(p[0]) + __uint_as_float(p[1]); }
DI int opaque_tid(int wv) { int lane; asm volatile("v_mbcnt_lo_u32_b32 %0, -1, 0\n\tv_mbcnt_hi_u32_b32 %0, -1, %0" : "=v"(lane)); return wv * 64 + lane; }
DI int crow(int i, int h) { return (i & 3) + 8 * (i >> 2) + 4 * h; }

typedef __attribute__((address_space(3))) unsigned lds_u32;
template <int ROWS> DI void glds_rows128(const bf16_t* src, long row_stride, char* img, int tid) {
    const int lane = tid & 63, wid = tid >> 6;
#pragma unroll
    for (int k = 0; k < ROWS / 64; ++k) {
        const int p = wid + NWV * k;
        const int row = p * 8 + (lane >> 3), pc = lane & 7, lc = pc ^ ((row >> 1) & 7);
        __builtin_amdgcn_global_load_lds((const unsigned*)(src + (long)row * row_stride + lc * 8), (lds_u32*)(img + p * 1024 + lane * 16), 16, 0, 0);
    }
}
DI void glds_rows64(const bf16_t* src, long row_stride, char* img, int tid) {
    const int lane = tid & 63, wid = tid >> 6;
    if (wid < 4) {
        const int row = wid * 16 + (lane >> 2), pc = lane & 3, lc = pc ^ ((row >> 2) & 3);
        __builtin_amdgcn_global_load_lds((const unsigned*)(src + (long)row * row_stride + lc * 8), (lds_u32*)(img + wid * 1024 + lane * 16), 16, 0, 0);
    }
}
#define MFMA32(a, b, c) __builtin_amdgcn_mfma_f32_32x32x16_bf16((a), (b), (c), 0, 0, 0)

template <class F> DI void for_items(int total, F f) {
    if ((gridDim.x & 7) == 0 && (total & 7) == 0) {
        const int x = blockIdx.x & 7, j = blockIdx.x >> 3, nb = gridDim.x >> 3, per = total >> 3;
        for (int t = j; t < per; t += nb) f(x * per + t);
    } else {
        for (int t = blockIdx.x; t < total; t += gridDim.x) f(t);
    }
}


template <class F> DI void for_items_dyn(int total, unsigned* heads, volatile unsigned* sh_idx, int wv, F f) {
    const int x = blockIdx.x & 7, per = total >> 3;
    for (;;) {
        __syncthreads();
        if (opaque_tid(wv) == 0) *sh_idx = atomicAdd(heads + x * 16, 1u);
        __syncthreads();
        const int q = (int)__builtin_amdgcn_readfirstlane(*sh_idx);
        if (q >= per) break;
        f(x * per + q);
    }
}

#define XB_TMO      128
#define XB_XCNT(j)  (256  + 64 * (j))
#define XB_XSUB(j)  (1280 + 64 * (j))
#define XB_XGEN(j)  (2304 + 64 * (j))
#define XB_TOP      3328
#define XB_TOPGEN   3392
#define XB_SPIN_CAP (1u << 18)
#define LAS __attribute__((address_space(3)))
DI unsigned xb_ld(unsigned* p)              { return __hip_atomic_load(p, __ATOMIC_RELAXED, __HIP_MEMORY_SCOPE_AGENT); }
DI unsigned xb_add(unsigned* p, unsigned v) { return __hip_atomic_fetch_add(p, v, __ATOMIC_RELAXED, __HIP_MEMORY_SCOPE_AGENT); }
DI unsigned xb_xcc_id() { return (unsigned)__builtin_amdgcn_s_getreg((3 << 11) | 20) & 0xFu; }
#define XB_SPIN(cond, bar) do { unsigned _sp = 0; while (cond) { __builtin_amdgcn_s_sleep(1); \
    if ((++_sp & 255u) == 0u) { if (xb_ld(&(bar)[XB_TMO])) break; if (_sp > XB_SPIN_CAP) { atomicAdd(&(bar)[XB_TMO], 1u); break; } } } } while (0)
struct XcdBarrier { unsigned* bar; unsigned x; volatile LAS unsigned* st; int wv; };
DI XcdBarrier xcd_barrier_post(unsigned* bar, volatile LAS unsigned* st, int wv) {
    XcdBarrier b; b.bar = bar; b.x = xb_xcc_id(); b.st = st; b.wv = wv;
    if (opaque_tid(wv) == 0) (void)xb_add(&bar[XB_XCNT(b.x)], 1u);
    return b;
}
DI void xcd_barrier_complete(unsigned* bar, unsigned x, unsigned& nloc, unsigned& nx) {
    const unsigned G = gridDim.x * gridDim.y * gridDim.z;
    unsigned sum, cnt, mine, sp = 0u;
    for (;;) {
        sum = 0u; cnt = 0u; mine = 0u;
#pragma unroll
        for (unsigned j = 0; j < 16; ++j) { const unsigned c = xb_ld(&bar[XB_XCNT(j)]); sum += c; cnt += (c > 0u) ? 1u : 0u; mine = (j == x) ? c : mine; }
        if (sum == G) break;
        __builtin_amdgcn_s_sleep(1);
        if ((++sp & 255u) == 0u) { if (xb_ld(&bar[XB_TMO])) break; if (sp > XB_SPIN_CAP) { atomicAdd(&bar[XB_TMO], 1u); break; } }
    }
    nloc = mine > 0u ? mine : 1u; nx = cnt > 0u ? cnt : 1u;
}
DI void xcd_barrier(const XcdBarrier& b) {
    asm volatile("s_waitcnt vmcnt(0)" ::: "memory");
    __syncthreads();
    if (opaque_tid(b.wv) == 0) {
        unsigned* bar = b.bar;
        asm volatile("" : "+s"(bar));
        __builtin_amdgcn_s_waitcnt(0);
        unsigned nloc = b.st[0], nx = b.st[1];
        if (nloc == 0u) { xcd_barrier_complete(bar, b.x, nloc, nx); b.st[0] = nloc; b.st[1] = nx; }
        const unsigned old = xb_add(&bar[XB_XSUB(b.x)], 1u);
        const unsigned gen = old / nloc;
        if (old + 1u == (gen + 1u) * nloc) {
            __builtin_amdgcn_fence(__ATOMIC_RELEASE, "agent");
            asm volatile("s_waitcnt vmcnt(0)" ::: "memory");
            const unsigned og = xb_add(&bar[XB_TOP], 1u);
            const unsigned tg = og / nx;
            if (og + 1u == (tg + 1u) * nx) xb_add(&bar[XB_TOPGEN], 1u);
            else XB_SPIN(xb_ld(&bar[XB_TOPGEN]) == tg, bar);
            __builtin_amdgcn_fence(__ATOMIC_ACQUIRE, "agent");
            xb_add(&bar[XB_XGEN(b.x)], 1u);
            asm volatile("s_waitcnt vmcnt(0)" ::: "memory");
        } else {
            XB_SPIN(xb_ld(&bar[XB_XGEN(b.x)]) == gen, bar);
            __builtin_amdgcn_fence(__ATOMIC_ACQUIRE, "agent");
            asm volatile("s_waitcnt vmcnt(0)" ::: "memory");
        }
    }
    __syncthreads();
}

DI int zsrc_col(int n) { if (n < 128) return 512 + n; if (n < 256) return 1536 + (n - 128); const int m = n - 256; return (m < 512) ? m : (m < 1408) ? 640 + (m - 512) : 1664 + (m - 1408); }
template <bool ZPERM> DI void transpose_convert(const float* __restrict__ W, const float* __restrict__ scale, bf16_t* __restrict__ Wt, int K, int N, int Npad, int ldo, long gtid, long gthreads) {
    const int KC = K >> 3;
    const long total = (long)Npad * KC;
    for (long it = gtid; it < total; it += gthreads) {
        const int n = (int)(it % Npad), kc = (int)(it / Npad);
        u32x4 o = {0u, 0u, 0u, 0u};
        if (n < N) {
            float v[8];
            const int ns = ZPERM ? zsrc_col(n) : n;
#pragma unroll
            for (int j = 0; j < 8; ++j) { const int k = kc * 8 + j; float w = W[(long)k * N + ns]; if (scale) w *= scale[k]; v[j] = w; }
            o = pack8(v);
        }
        *(u32x4*)(Wt + (long)n * ldo + kc * 8) = o;
    }
}

DI void phase_prep(const Params& P) {
    const long gtid = (long)blockIdx.x * blockDim.x + opaque_tid(P.wv), gth = (long)gridDim.x * blockDim.x;
    for (int l = 0; l < 2; ++l) {
        transpose_convert<true>(P.w_in + (long)l * 1024 * IN_COLS, P.norm_g + l * 1024, P.winT() + (long)l * IN_PAD * LDW, 1024, IN_COLS, IN_PAD, LDW, gtid, gth);
        transpose_convert<false>(P.w_out + (long)l * 1024 * 1024, nullptr, P.woutT() + (long)l * 1024 * LDW, 1024, 1024, 1024, LDW, gtid, gth);
        transpose_convert<false>(P.c_wuq + (long)l * 192 * 384, P.c_qn + l * 192, P.wuqT() + (long)l * 512 * 192, 192, 384, 512, 192, gtid, gth);
        transpose_convert<false>(P.c_wukv + (long)l * 128 * 512, P.c_kvn + l * 128, P.wukvT() + (long)l * 512 * 128, 128, 512, 512, 128, gtid, gth);
    }
    for (long it = gtid; it < 2048 * 16; it += gth) {
        const int p = (int)(it >> 4), i = (int)(it & 15);
        const float inv = powf(10000.0f, -(float)i / 16.0f);
        const float ang = (float)p * inv;
        float s, c; sincosf(ang, &s, &c);
        P.t32()[it] = make_float2(c, s);
    }
    for (long it = gtid; it < 2048 * 32; it += gth) {
        const int p = (int)(it >> 5), i = (int)(it & 31);
        const float inv = powf(10000.0f, -(float)i / 32.0f);
        const float ang = (float)p * inv;
        float s, c; sincosf(ang, &s, &c);
        P.t32()[T64_OFF + it] = make_float2(c, s);
    }
}

template <bool FINAL> DI void phase_norm(const float* xin, bf16_t* xb, float* outp, const float* g, int wv) {
    const int tid = opaque_tid(wv), lane = tid & 63;
    const int gw = blockIdx.x * NWV + (tid >> 6), nw = gridDim.x * NWV;
    constexpr int RW = 2;
    for (int row0 = gw * RW; row0 < NTOK; row0 += nw * RW) {
        float4 v[RW][4];
#pragma unroll
        for (int u = 0; u < RW; ++u) {
            const float4* p = (const float4*)(xin + (long)(row0 + u) * 1024);
#pragma unroll
            for (int i = 0; i < 4; ++i) v[u][i] = ld_nt((const float*)(p + lane + 64 * i));
        }
        float4 gg[4];
        if (FINAL) {
#pragma unroll
            for (int i = 0; i < 4; ++i) gg[i] = ((const float4*)g)[lane + 64 * i];
        }
#pragma unroll
        for (int u = 0; u < RW; ++u) {
            float ss = 0.f;
#pragma unroll
            for (int i = 0; i < 4; ++i) ss += v[u][i].x * v[u][i].x + v[u][i].y * v[u][i].y + v[u][i].z * v[u][i].z + v[u][i].w * v[u][i].w;
            ss = wave_sum(ss);
            const float rinv = rsqrtf(ss * (1.0f / 1024.0f) + EPS);
            const long row = row0 + u;
#pragma unroll
            for (int i = 0; i < 4; ++i) {
                if (FINAL) {
                    float4 o; o.x = v[u][i].x * rinv * gg[i].x; o.y = v[u][i].y * rinv * gg[i].y; o.z = v[u][i].z * rinv * gg[i].z; o.w = v[u][i].w * rinv * gg[i].w;
                    st_nt(outp + row * 1024 + (lane + 64 * i) * 4, o);
                } else {
                    u32x2 o; o[0] = pk2(v[u][i].x * rinv, v[u][i].y * rinv); o[1] = pk2(v[u][i].z * rinv, v[u][i].w * rinv);
                    *(u32x2*)(xb + row * LDX + (lane + 64 * i) * 4) = o;
                }
            }
        }
    }
}

struct GemmArgs { const bf16_t* A; int lda; const bf16_t* Bt; int ldb; int K; int wv; };

template <class Epi>
DI void gemm_tile(const GemmArgs& g, int m0, int n0, char* lds, const Epi& epi) {
    const int tid = opaque_tid(g.wv), lane = tid & 63, wid = tid >> 6, wm = wid >> 2, wn = wid & 3;
    const int r = lane & 31, h = lane >> 5;
    f32x16 acc[4][2];
#pragma unroll
    for (int a = 0; a < 4; ++a)
#pragma unroll
        for (int b = 0; b < 2; ++b)
#pragma unroll
            for (int i = 0; i < 16; ++i) acc[a][b][i] = 0.f;
    const bf16_t* ap = g.A + (long)m0 * g.lda;
    const bf16_t* bp = g.Bt + (long)n0 * g.ldb;
    const int nk = g.K >> 6;
    glds_rows128<256>(ap, g.lda, lds, tid);
    glds_rows128<256>(bp, g.ldb, lds + 32768, tid);
    __syncthreads();
    int aoff[4], boff[2];
#pragma unroll
    for (int i = 0; i < 4; ++i) aoff[i] = (wm * 128 + i * 32 + r) * 128;
#pragma unroll
    for (int i = 0; i < 2; ++i) boff[i] = 32768 + (wn * 64 + i * 32 + r) * 128;
    const int swz = (r >> 1) & 7;
    for (int kt = 0; kt < nk; ++kt) {
        if (kt + 1 < nk) {
            char* ls = lds + ((kt + 1) & 1) * 65536;
            glds_rows128<256>(ap + (kt + 1) * 64, g.lda, ls, tid);
            glds_rows128<256>(bp + (kt + 1) * 64, g.ldb, ls + 32768, tid);
        }
        const char* st = lds + (kt & 1) * 65536;
#pragma unroll
        for (int s = 0; s < 4; ++s) {
            const int co = ((2 * s + h) ^ swz) << 4;
            bf16x8 af[4], bfr[2];
#pragma unroll
            for (int i = 0; i < 4; ++i) af[i] = *(const bf16x8*)(st + aoff[i] + co);
#pragma unroll
            for (int i = 0; i < 2; ++i) bfr[i] = *(const bf16x8*)(st + boff[i] + co);
#pragma unroll
            for (int a = 0; a < 4; ++a)
#pragma unroll
                for (int b = 0; b < 2; ++b) acc[a][b] = MFMA32(bfr[b], af[a], acc[a][b]);
        }
        __syncthreads();
    }
    epi(acc, lds, m0, n0, tid);
    __syncthreads();
}

DI int img32(int row, int col) { return row * 512 + ((((col >> 3) ^ (row & 31))) << 4) + (col & 7) * 2; }
DI int img16(int row, int col) { return row * 256 + ((((col >> 3) ^ (row & 15))) << 4) + (col & 7) * 2; }
template <bool W32> DI void epi_stage_rm(const f32x16 (&acc)[4][2], char* img, int tid, int cbase, const float* rtab) {
    const int lane = tid & 63, wid = tid >> 6, wm = wid >> 2, r = lane & 31, h = lane >> 5;
#pragma unroll
    for (int a = 0; a < 4; ++a)
#pragma unroll
        for (int b = 0; b < 2; ++b) {
            const int row = wm * 128 + a * 32 + r;
            const float rs = rtab[row];
#pragma unroll
            for (int g4 = 0; g4 < 4; ++g4) {
                const int col = cbase + b * 32 + 8 * g4 + 4 * h;
                u32x2 v; v[0] = pk2(acc[a][b][4 * g4] * rs, acc[a][b][4 * g4 + 1] * rs); v[1] = pk2(acc[a][b][4 * g4 + 2] * rs, acc[a][b][4 * g4 + 3] * rs);
                *(u32x2*)(img + (W32 ? img32(row, col) : img16(row, col))) = v;
            }
        }
}
DI void epi_stage_vt(const f32x16 (&acc)[4][2], char* img, int tid, int nbase, const float* rtab) {
    const int lane = tid & 63, wid = tid >> 6, wm = wid >> 2, r = lane & 31, h = lane >> 5;
#pragma unroll
    for (int a = 0; a < 4; ++a)
#pragma unroll
        for (int b = 0; b < 2; ++b) {
            const int m = wm * 128 + a * 32 + r;
            const float rs = rtab[m];
#pragma unroll
            for (int i = 0; i < 16; ++i) {
                const int n = nbase + b * 32 + crow(i, h);
                *(bf16_t*)(img + img32(n, m)) = (bf16_t)(pk2(acc[a][b][i] * rs, 0.f) & 0xffffu);
            }
        }
}


typedef float f32x4 __attribute__((ext_vector_type(4)));
namespace g8 {
constexpr int BM = 256, BK = 64, HALF = 128, HT = HALF * BK;
DI int lds_byte(int r, int c) { const int st = (r >> 4) * 2 + (c >> 5), rr = r & 15, cc = c & 31, ob = rr * 64 + cc * 2; return st * 1024 + (ob ^ (((ob >> 9) & 1) << 5)); }
DI void stage_rc(int b, int& R, int& C) { const int st = b / 1024, sb = b % 1024, swz = sb ^ (((sb >> 9) & 1) << 5); R = (st >> 1) * 16 + swz / 64; C = (st & 1) * 32 + (swz % 64) / 2; }
}
template <class Epi>
DI void gemm_tile8(const GemmArgs& g, int m0, int n0, char* lds, const Epi& epi) {
    using namespace g8;
    const bf16_t* A = g.A; const bf16_t* Bt = g.Bt;
    const long lda = g.lda, ldb = g.ldb;
    const int tid = opaque_tid(g.wv);
    const int wid = tid >> 6, lane = tid & 63, wr = wid >> 2, wc = wid & 3, fr = lane & 15, fq = lane >> 4;
    const int lane_off = lds_byte(fr, fq * 8);
    const char* a_rd = lds + wr * 8192 + lane_off;
    const char* b_rd = lds + 65536 + wc * 4096 + lane_off;
    int sr, sc; stage_rc(tid * 16, sr, sc);
    const unsigned a_src = (unsigned)((sr * (int)lda + sc) * 2);
    const unsigned b_src = (unsigned)((sr * (int)ldb + sc) * 2);
    char* st_dst = lds + tid * 16;
#define SA(b, h) (((b) * 2 + (h)) * 16384)
#define SB(b, h) (65536 + ((b) * 2 + (h)) * 16384)
#define STAGE(P_, BASE, LD, br, kt) do { const char* _gb = (const char*)((BASE) + (long)(br) * (LD) + (long)(kt) * BK); const unsigned _so = (&(BASE) == &A) ? a_src : b_src; \
    _Pragma("unroll") for (int _i = 0; _i < 2; ++_i) \
      __builtin_amdgcn_global_load_lds((const unsigned*)(_gb + (size_t)(_so + (unsigned)(_i * 128 * (int)(LD)))), (lds_u32*)(st_dst + (P_) + _i * 8192), 16, 0, 0); } while (0)
#define LDA(dst, b, h) _Pragma("unroll") for (int m = 0; m < 4; ++m) _Pragma("unroll") for (int k = 0; k < 2; ++k) \
    dst[m][k] = *reinterpret_cast<const bf16x8*>(a_rd + SA(b, h) + (2 * m + k) * 1024)
#define LDB(dst, b, h) _Pragma("unroll") for (int n = 0; n < 2; ++n) _Pragma("unroll") for (int k = 0; k < 2; ++k) \
    dst[n][k] = *reinterpret_cast<const bf16x8*>(b_rd + (SB(b, h) - 65536) + (2 * n + k) * 1024)
#define MMA(ai, bj, At_, Bt_) do { __builtin_amdgcn_s_setprio(1); \
    _Pragma("unroll") for (int m = 0; m < 4; ++m) _Pragma("unroll") for (int n = 0; n < 2; ++n) _Pragma("unroll") for (int k = 0; k < 2; ++k) \
      acc[ai][bj][m][n] = __builtin_amdgcn_mfma_f32_16x16x32_bf16(Bt_[n][k], At_[m][k], acc[ai][bj][m][n], 0, 0, 0); \
    __builtin_amdgcn_s_setprio(0); } while (0)
#define WAIT_V(n) asm volatile("s_waitcnt vmcnt(" #n ")" ::: "memory")
#define WAIT_L(n) asm volatile("s_waitcnt lgkmcnt(" #n ")" ::: "memory")
#define BAR __builtin_amdgcn_s_barrier()
#define SCHED __builtin_amdgcn_sched_barrier(0)
    const int brow = m0, bcol = n0;
    f32x4 acc[2][2][4][2];
#pragma unroll
    for (int a = 0; a < 2; ++a)
#pragma unroll
        for (int b = 0; b < 2; ++b)
#pragma unroll
            for (int m = 0; m < 4; ++m)
#pragma unroll
                for (int n = 0; n < 2; ++n) acc[a][b][m][n] = (f32x4){0.f, 0.f, 0.f, 0.f};
    bf16x8 At[4][2], B0[2][2], B1[2][2];
    const int nt = g.K / BK;
    STAGE(SB(0, 0), Bt, ldb, bcol, 0); STAGE(SA(0, 0), A, lda, brow, 0);
    STAGE(SB(0, 1), Bt, ldb, bcol + HALF, 0); STAGE(SA(0, 1), A, lda, brow + HALF, 0);
    if (wr == 1) BAR;
    WAIT_V(4); BAR;
    STAGE(SB(1, 0), Bt, ldb, bcol, 1); STAGE(SA(1, 0), A, lda, brow, 1); STAGE(SB(1, 1), Bt, ldb, bcol + HALF, 1);
    WAIT_V(6); BAR;
    for (int t = 0; t < nt - 2; t += 2) {
        LDB(B0, 0, 0); SCHED; LDA(At, 0, 0); STAGE(SA(1, 1), A, lda, brow + HALF, t + 1);
        WAIT_L(8); BAR; WAIT_L(0); MMA(0, 0, At, B0); BAR; SCHED;
        LDB(B1, 0, 1); STAGE(SB(0, 0), Bt, ldb, bcol, t + 2);
        BAR; WAIT_L(0); MMA(0, 1, At, B1); BAR;
        LDA(At, 0, 1); STAGE(SA(0, 0), A, lda, brow, t + 2);
        BAR; WAIT_L(0); MMA(1, 0, At, B0); BAR; SCHED;
        STAGE(SB(0, 1), Bt, ldb, bcol + HALF, t + 2);
        WAIT_V(6); BAR; MMA(1, 1, At, B1); BAR;
        LDB(B0, 1, 0); SCHED; LDA(At, 1, 0); STAGE(SA(0, 1), A, lda, brow + HALF, t + 2);
        WAIT_L(8); BAR; WAIT_L(0); MMA(0, 0, At, B0); BAR; SCHED;
        LDB(B1, 1, 1); STAGE(SB(1, 0), Bt, ldb, bcol, t + 3);
        BAR; WAIT_L(0); MMA(0, 1, At, B1); BAR;
        LDA(At, 1, 1); STAGE(SA(1, 0), A, lda, brow, t + 3);
        BAR; WAIT_L(0); MMA(1, 0, At, B0); BAR; SCHED;
        STAGE(SB(1, 1), Bt, ldb, bcol + HALF, t + 3);
        WAIT_V(6); BAR; MMA(1, 1, At, B1); BAR;
    }
    { LDB(B0, 0, 0); LDA(At, 0, 0); STAGE(SA(1, 1), A, lda, brow + HALF, nt - 1);
      BAR; WAIT_L(0); MMA(0, 0, At, B0); BAR;
      LDB(B1, 0, 1); BAR; WAIT_L(0); MMA(0, 1, At, B1); BAR;
      LDA(At, 0, 1); WAIT_V(4); BAR; WAIT_L(0); MMA(1, 0, At, B0); MMA(1, 1, At, B1); BAR; }
    { LDB(B0, 1, 0); LDA(At, 1, 0); WAIT_V(2); BAR; WAIT_L(0); MMA(0, 0, At, B0); BAR;
      LDB(B1, 1, 1); WAIT_V(0); BAR; WAIT_L(0); MMA(0, 1, At, B1); BAR;
      LDA(At, 1, 1); BAR; WAIT_L(0); MMA(1, 0, At, B0); MMA(1, 1, At, B1); BAR; }
    if (wr == 0) BAR;
#undef SA
#undef SB
#undef STAGE
#undef LDA
#undef LDB
#undef MMA
#undef WAIT_V
#undef WAIT_L
#undef BAR
#undef SCHED
    __syncthreads();
    epi(acc, lds, m0, n0, opaque_tid(g.wv));
    __syncthreads();
}
DI void epi8_stage_rm(const f32x4 (&acc)[2][2][4][2], char* img, int tid, const float* rinv) {
    const int wid = tid >> 6, lane = tid & 63, wr = wid >> 2, wc = wid & 3, fr = lane & 15, fq = lane >> 4;
#pragma unroll
    for (int ai = 0; ai < 2; ++ai)
#pragma unroll
        for (int bj = 0; bj < 2; ++bj)
#pragma unroll
            for (int m = 0; m < 4; ++m)
#pragma unroll
                for (int n = 0; n < 2; ++n) {
                    const int row = ai * 128 + wr * 64 + m * 16 + fr, col = bj * 128 + wc * 32 + n * 16 + fq * 4;
                    const f32x4 a = acc[ai][bj][m][n] * rinv[row];
                    u32x2 v; v[0] = pk2(a[0], a[1]); v[1] = pk2(a[2], a[3]);
                    *(u32x2*)(img + img32(row, col)) = v;
                }
}
DI void epi8_stage_vt(const f32x4 (&acc)[2][2][4][2], char* img, int tid, const float* rinv) {
    const int wid = tid >> 6, lane = tid & 63, wr = wid >> 2, wc = wid & 3, fr = lane & 15, fq = lane >> 4;
#pragma unroll
    for (int ai = 0; ai < 2; ++ai)
#pragma unroll
        for (int bj = 0; bj < 2; ++bj)
#pragma unroll
            for (int m = 0; m < 4; ++m)
#pragma unroll
                for (int n = 0; n < 2; ++n) {
                    const int row = ai * 128 + wr * 64 + m * 16 + fr, col = bj * 128 + wc * 32 + n * 16 + fq * 4;
                    const f32x4 a = acc[ai][bj][m][n] * rinv[row];
#pragma unroll
                    for (int j = 0; j < 4; ++j) *(bf16_t*)(img + img32(col + j, row)) = (bf16_t)(pk2(a[j], 0.f) & 0xffffu);
                }
}

DI u32x4 kside_chunk(const char* lds, int row, int chbase, int c, int kind, int t, const float* akn, const float2* tab) {
    const char* rp = lds + row * 512;
    const int sw = row & 31;
    float v[8], pv[8];
    const int pc = (kind == 2) ? (c ^ 4) : (c ^ 2);
    unpack8(*(const u32x4*)(rp + (((chbase + c) ^ sw) << 4)), v);
    unpack8(*(const u32x4*)(rp + (((chbase + pc) ^ sw) << 4)), pv);
    if (kind == 1) {
        float ss = 0.f;
#pragma unroll
        for (int cc = 0; cc < 8; ++cc) {
            float w[8]; unpack8(*(const u32x4*)(rp + (((chbase + cc) ^ sw) << 4)), w);
#pragma unroll
            for (int j = 0; j < 8; ++j) ss += w[j] * w[j];
        }
        const float rinv = rsqrtf(ss * (1.0f / 64.0f) + EPS);
#pragma unroll
        for (int j = 0; j < 8; ++j) { v[j] *= rinv * akn[c * 8 + j]; pv[j] *= rinv * akn[pc * 8 + j]; }
    }
    int tidx; bool first;
    if (kind == 1) { const int pos = (c < 4) ? (t >> 6) : (t & 63); tidx = pos * 16 + (c & 1) * 8; first = !(c & 2); }
    else if (kind == 2) { tidx = T64_OFF + t * 32 + (c & 3) * 8; first = (c < 4); }
    else { tidx = t * 16 + (c & 1) * 8; first = !(c & 2); }
    float o[8];
#pragma unroll
    for (int j = 0; j < 8; ++j) { const float2 cs = tab[tidx + j]; o[j] = v[j] * cs.x + (first ? -pv[j] : pv[j]) * cs.y; }
    return pack8(o);
}

struct EpiZ {
    bf16_t *z, *vtA, *vtB; const float* akn; const float2* tab; const float* psum;
    DI void operator()(const f32x4 (&acc)[2][2][4][2], char* lds, int m0, int n0, int tid) const {
        float* rl = (float*)(lds + LDS_RINV);
        if (tid < 256) {
            float rv = 1.0f;
            if (psum) {
                const float4* pp = (const float4*)(psum + (long)(m0 + tid) * 8);
                const float4 p0 = pp[0], p1 = pp[1];
                rv = rsqrtf(((p0.x + p0.y) + (p0.z + p0.w) + (p1.x + p1.y) + (p1.z + p1.w)) * (1.0f / 1024.0f) + EPS);
            }
            rl[tid] = rv;
        }
        __syncthreads();
        if (n0 == 0) {
            epi8_stage_vt(acc, lds, tid, rl);
            __syncthreads();
            const int b = m0 >> 11, t0 = m0 & 2047;
#pragma unroll
            for (int k = 0; k < 16; ++k) {
                const int idx = tid + NT * k, n = idx >> 5, ch = idx & 31;
                const u32x4 v = *(const u32x4*)(lds + n * 512 + ((ch ^ (n & 31)) << 4));
                bf16_t* vt = (n < 128) ? vtA : vtB;
                *(u32x4*)(vt + (long)(b * 128 + (n & 127)) * VTS + t0 + ch * 8) = v;
            }
        } else {
            epi8_stage_rm(acc, lds, tid, rl);
            __syncthreads();
            const int ch_limit = (IN_COLS - n0) >> 3;
            const int kind = (n0 == 512) ? 1 : (n0 == 1536) ? 2 : (n0 == 2304) ? 3 : 0;
            const int klo = (kind == 1) ? 16 : (kind == 3) ? 8 : 0, khi = (kind == 1) ? 32 : (kind == 2) ? 16 : (kind == 3) ? 12 : 0;
#pragma unroll
            for (int k = 0; k < 16; ++k) {
                const int idx = tid + NT * k, row = idx >> 5, ch = idx & 31;
                const u32x4 v = *(const u32x4*)(lds + row * 512 + ((ch ^ (row & 31)) << 4));
                if (ch < ch_limit && !(ch >= klo && ch < khi)) *(u32x4*)(z + (long)(m0 + row) * IN_COLS + n0 + ch * 8) = v;
            }
            if (kind) {
                const int lg = (kind == 3) ? 2 : 4;
                const int per = (256 << lg) / NT;
#pragma unroll 1
                for (int i0 = 0; i0 < per; i0 += 4) {
                    u32x4 o[4]; int rr[4], cc[4];
#pragma unroll
                    for (int u = 0; u < 4; ++u) {
                        const int e = tid + NT * (i0 + u), row = e >> lg, hc = e & ((1 << lg) - 1);
                        rr[u] = row; cc[u] = klo + hc;
                        if (i0 + u < per) o[u] = kside_chunk(lds, row, (kind == 3) ? klo : klo + (hc & ~7), (kind == 3) ? hc : (hc & 7), kind, (m0 + row) & 2047, akn, tab);
                    }
#pragma unroll
                    for (int u = 0; u < 4; ++u)
                        if (i0 + u < per) *(u32x4*)(z + (long)(m0 + rr[u]) * IN_COLS + n0 + cc[u] * 8) = o[u];
                }
            }
        }
    }
};
struct EpiQC {
    bf16_t* qc;
    DI void operator()(const f32x16 (&acc)[4][2], char* lds, int m0, int n0, int tid) const {
        const int wn = (tid >> 6) & 3;
        epi_stage_rm<true>(acc, lds, tid, wn * 64, (const float*)(lds + LDS_RINV));
        __syncthreads();
        const int ch_limit = (384 - n0) >> 3;
#pragma unroll
        for (int k = 0; k < 16; ++k) {
            const int idx = tid + NT * k, row = idx >> 5, ch = idx & 31;
            const u32x4 v = *(const u32x4*)(lds + row * 512 + ((ch ^ (row & 31)) << 4));
            if (ch < ch_limit) *(u32x4*)(qc + (long)(m0 + row) * 384 + n0 + ch * 8) = v;
        }
    }
};
struct EpiKV {
    bf16_t *kc, *vtC;
    DI void operator()(const f32x16 (&acc)[4][2], char* lds, int m0, int n0, int tid) const {
        const int wn = (tid >> 6) & 3, hl = wn >> 1, head0 = (n0 >> 8) * 2;
        if ((wn & 1) == 0) epi_stage_rm<false>(acc, lds, tid, hl * 64, (const float*)(lds + LDS_RINV));
        else epi_stage_vt(acc, lds + 65536, tid, hl * 64, (const float*)(lds + LDS_RINV));
        __syncthreads();
        const int b = m0 >> 11, t0 = m0 & 2047;
#pragma unroll
        for (int k = 0; k < 8; ++k) {
            const int idx = tid + NT * k, row = idx >> 4, ch = idx & 15;
            const u32x4 v = *(const u32x4*)(lds + row * 256 + ((ch ^ (row & 15)) << 4));
            *(u32x4*)(kc + (long)(m0 + row) * KCS + (head0 + (ch >> 3)) * 64 + (ch & 7) * 8) = v;
        }
#pragma unroll
        for (int k = 0; k < 8; ++k) {
            const int idx = tid + NT * k, n = idx >> 5, ch = idx & 31;
            const u32x4 v = *(const u32x4*)(lds + 65536 + n * 512 + ((ch ^ (n & 31)) << 4));
            *(u32x4*)(vtC + (long)((b * 4 + head0 + (n >> 6)) * 64 + (n & 63)) * VTS + t0 + ch * 8) = v;
        }
    }
};
struct EpiOut {
    const float* xin; float* out; bf16_t* xb2; float* psum;
    DI void operator()(const f32x4 (&acc)[2][2][4][2], char* lds, int m0, int n0, int tid) const {
        const int wid = tid >> 6, lane = tid & 63, wr = wid >> 2, wc = wid & 3, fr = lane & 15, fq = lane >> 4;
#pragma unroll
        for (int p = 0; p < 2; ++p) {
#pragma unroll
            for (int ai = 0; ai < 2; ++ai)
#pragma unroll
                for (int m = 0; m < 4; ++m)
#pragma unroll
                    for (int n = 0; n < 2; ++n) {
                        const int row = ai * 128 + wr * 64 + m * 16 + fr, ch = (wc * 32 + n * 16 + fq * 4) >> 2;
                        const f32x4 a = acc[ai][p][m][n];
                        float4 v; v.x = a[0]; v.y = a[1]; v.z = a[2]; v.w = a[3];
                        *(float4*)(lds + row * 512 + ((ch ^ (row & 31)) << 4)) = v;
                    }
            __syncthreads();
#pragma unroll 1
            for (int k2 = 0; k2 < 4; ++k2) {
                float4 xv[4];
#pragma unroll
                for (int k = 0; k < 4; ++k) { const int idx = tid + NT * (k2 * 4 + k), row = idx >> 5, ch = idx & 31; xv[k] = ld_nt(xin + (long)(m0 + row) * 1024 + n0 + p * 128 + ch * 4); }
#pragma unroll
                for (int k = 0; k < 4; ++k) {
                    const int idx = tid + NT * (k2 * 4 + k), row = idx >> 5, ch = idx & 31;
                    const float4 v = *(const float4*)(lds + row * 512 + ((ch ^ (row & 31)) << 4));
                    float4 o; o.x = xv[k].x + v.x; o.y = xv[k].y + v.y; o.z = xv[k].z + v.z; o.w = xv[k].w + v.w;
                    if (xb2) st_nt(out + (long)(m0 + row) * 1024 + n0 + p * 128 + ch * 4, o);
                    else *(float4*)(out + (long)(m0 + row) * 1024 + n0 + p * 128 + ch * 4) = o;
                    if (xb2) {
                        u32x2 ob; ob[0] = pk2(o.x, o.y); ob[1] = pk2(o.z, o.w);
                        *(u32x2*)(xb2 + (long)(m0 + row) * LDX + n0 + p * 128 + ch * 4) = ob;
                        float ss = o.x * o.x + o.y * o.y + o.z * o.z + o.w * o.w;
                        ss += __shfl_xor(ss, 1); ss += __shfl_xor(ss, 2); ss += __shfl_xor(ss, 4); ss += __shfl_xor(ss, 8); ss += __shfl_xor(ss, 16);
                        if (ch == 0) psum[(long)(m0 + row) * 8 + (n0 >> 8) * 2 + p] = ss;
                    }
                }
            }
            __syncthreads();
        }
    }
};

DI void phase_kprep(const Params& P, int l) {
    const int tid = opaque_tid(P.wv), lane = tid & 63;
    const int gw = blockIdx.x * NWV + (tid >> 6), nw = gridDim.x * NWV;
    constexpr int TK = 4;
    const int grp = (lane < 16) ? 0 : (lane < 32) ? 1 : 2;
    const int c = (grp == 2) ? (lane & 3) : (lane & 7);
    const int off1 = (grp == 0) ? OFF_AK + lane * 8 : (grp == 1) ? OFF_BK + (lane - 16) * 8 : OFF_CKR + (lane & 3) * 8;
    const int hl = lane & 31;
    const bool lo = lane < 32;
    const bool valid2 = lo ? (hl < 24) : (hl < 16);
    const int off2 = (lo ? OFF_CQ : OFF_CKV) + (valid2 ? hl : 0) * 8;
    const bool first = (grp == 1) ? (c < 4) : !(c & 2);
    float kn[8];
#pragma unroll
    for (int j = 0; j < 8; ++j) kn[j] = (grp == 0) ? P.a_kn[l * 64 + c * 8 + j] : 1.0f;
    for (int tok0 = gw * TK; tok0 < NTOK; tok0 += nw * TK) {
        u32x4 raw1[TK], raw2[TK];
        float2 cs[TK][8];
#pragma unroll
        for (int u = 0; u < TK; ++u) {
            const int tok = tok0 + u, t = tok & 2047;
            const bf16_t* zr = P.z() + (long)tok * IN_COLS;
            raw1[u] = *(const u32x4*)(zr + off1);
            raw2[u] = *(const u32x4*)(zr + off2);
            int tidx;
            if (grp == 0) { const int pos = (c < 4) ? (t >> 6) : (t & 63); tidx = pos * 16 + (c & 1) * 8; }
            else if (grp == 1) tidx = T64_OFF + t * 32 + (c & 3) * 8;
            else tidx = t * 16 + (c & 1) * 8;
            const float2* tb = P.t32() + tidx;
#pragma unroll
            for (int j = 0; j < 8; ++j) cs[u][j] = tb[j];
        }
#pragma unroll
        for (int u = 0; u < TK; ++u) {
            bf16_t* zr = P.z() + (long)(tok0 + u) * IN_COLS;
            {
                float v[8]; unpack8(raw1[u], v);
                float ss = 0.f;
#pragma unroll
                for (int j = 0; j < 8; ++j) ss += v[j] * v[j];
                ss += __shfl_xor(ss, 1); ss += __shfl_xor(ss, 2); ss += __shfl_xor(ss, 4);
                if (grp == 0) {
                    const float rinv = rsqrtf(ss * (1.0f / 64.0f) + EPS);
#pragma unroll
                    for (int j = 0; j < 8; ++j) v[j] = v[j] * rinv * kn[j];
                }
                float o[8];
#pragma unroll
                for (int j = 0; j < 8; ++j) {
                    const float p2 = __shfl_xor(v[j], 2), p4 = __shfl_xor(v[j], 4);
                    const float pv = (grp == 1) ? p4 : p2;
                    o[j] = v[j] * cs[u][j].x + (first ? -pv : pv) * cs[u][j].y;
                }
                if (lane < 36) *(u32x4*)(zr + off1) = pack8(o);
            }
            {
                float v[8]; unpack8(raw2[u], v);
                float ss = 0.f;
                if (valid2) {
#pragma unroll
                    for (int j = 0; j < 8; ++j) ss += v[j] * v[j];
                }
                ss += __shfl_xor(ss, 1); ss += __shfl_xor(ss, 2); ss += __shfl_xor(ss, 4); ss += __shfl_xor(ss, 8); ss += __shfl_xor(ss, 16);
                const float rinv = rsqrtf(ss * (lo ? (1.0f / 192.0f) : (1.0f / 128.0f)) + EPS);
#pragma unroll
                for (int j = 0; j < 8; ++j) v[j] *= rinv;
                if (valid2) *(u32x4*)(zr + off2) = pack8(v);
            }
        }
    }
}

template <int TYPE, int NQT>
DI void attn_item(const Params& P, int l, int b, int kvh, int headA, int qbA, int headB, int qbB, char* lds) {
    constexpr int NS = (TYPE == 2) ? 6 : 4;
    const int tid = opaque_tid(P.wv), lane = tid & 63, wid = P.wv, r = lane & 31, h = lane >> 5;
    const int head = (wid >> 2) ? headB : headA, qb = (wid >> 2) ? qbB : qbA;
    const int q0 = qb * (128 * NQT) + (wid & 3) * (32 * NQT);
    const float sc = ((TYPE == 2) ? 0.10206207261596577f : 0.125f) * LOG2E;
    int skipmax = 0;
    if (TYPE == 0) {
        float wq = fabsf(P.a_qn[l * 64 + lane]), wk = fabsf(P.a_kn[l * 64 + lane]);
#pragma unroll
        for (int o = 32; o >= 1; o >>= 1) { wq = fmaxf(wq, __shfl_xor(wq, o)); wk = fmaxf(wk, __shfl_xor(wk, o)); }
        skipmax = __builtin_amdgcn_readfirstlane((8.0f * wq * wk * LOG2E * 1.05f < 30.0f) ? 1 : 0);
    }

    bf16x8 qf[NQT][NS];
#pragma unroll
    for (int qt = 0; qt < NQT; ++qt) {
        const int tq = q0 + qt * 32 + r;
        const long tok = (long)b * SEQ + tq;
        const bf16_t* src = (TYPE == 0) ? P.z() + tok * IN_COLS + OFF_AQ + head * 64 : (TYPE == 1) ? P.z() + tok * IN_COLS + OFF_BQ + head * 64 : P.qc() + tok * 384 + head * 96;
        float qv[NS][8];
#pragma unroll
        for (int s = 0; s < NS; ++s) { const u32x4 raw = *(const u32x4*)(src + 16 * s + 8 * h); unpack8(raw, qv[s]); }
        if (TYPE == 0) {
            float ss = 0.f;
#pragma unroll
            for (int s = 0; s < 4; ++s)
#pragma unroll
                for (int j = 0; j < 8; ++j) ss += qv[s][j] * qv[s][j];
            ss = xhalf_sum(ss);
            const float rinv = rsqrtf(ss * (1.0f / 64.0f) + EPS);
#pragma unroll
            for (int s = 0; s < 4; ++s)
#pragma unroll
                for (int j = 0; j < 8; ++j) qv[s][j] *= rinv * P.a_qn[l * 64 + 16 * s + 8 * h + j];
            const float2* tr = P.t32() + (tq >> 6) * 16 + 8 * h;
            const float2* tc = P.t32() + (tq & 63) * 16 + 8 * h;
#pragma unroll
            for (int j = 0; j < 8; ++j) {
                const float2 a = tr[j], c2 = tc[j];
                const float x0 = qv[0][j], x1 = qv[1][j], y0 = qv[2][j], y1 = qv[3][j];
                qv[0][j] = x0 * a.x - x1 * a.y; qv[1][j] = x1 * a.x + x0 * a.y;
                qv[2][j] = y0 * c2.x - y1 * c2.y; qv[3][j] = y1 * c2.x + y0 * c2.y;
            }
        } else if (TYPE == 1) {
            const float2* t0 = P.t32() + T64_OFF + tq * 32 + 8 * h;
#pragma unroll
            for (int j = 0; j < 8; ++j) {
                const float2 a = t0[j], c2 = t0[16 + j];
                const float x0 = qv[0][j], x1 = qv[2][j], y0 = qv[1][j], y1 = qv[3][j];
                qv[0][j] = x0 * a.x - x1 * a.y; qv[2][j] = x1 * a.x + x0 * a.y;
                qv[1][j] = y0 * c2.x - y1 * c2.y; qv[3][j] = y1 * c2.x + y0 * c2.y;
            }
        } else {
            const float2* t0 = P.t32() + tq * 16 + 8 * h;
#pragma unroll
            for (int j = 0; j < 8; ++j) {
                const float2 a = t0[j];
                const float x0 = qv[NS - 2][j], x1 = qv[NS - 1][j];
                qv[NS - 2][j] = x0 * a.x - x1 * a.y; qv[NS - 1][j] = x1 * a.x + x0 * a.y;
            }
        }
#pragma unroll
        for (int s = 0; s < NS; ++s) {
            float tmp[8];
#pragma unroll
            for (int j = 0; j < 8; ++j) tmp[j] = qv[s][j] * sc;
            qf[qt][s] = __builtin_bit_cast(bf16x8, pack8(tmp));
        }
    }

    const bf16_t* kbase; long kstride; const bf16_t* vbase; const bf16_t* krbase = nullptr;
    if (TYPE == 0) { kbase = P.z() + (long)b * SEQ * IN_COLS + OFF_AK + kvh * 64; kstride = IN_COLS; vbase = P.vtA() + (long)((b * 2 + kvh) * 64) * VTS; }
    else if (TYPE == 1) { kbase = P.z() + (long)b * SEQ * IN_COLS + OFF_BK + kvh * 64; kstride = IN_COLS; vbase = P.vtB() + (long)((b * 2 + kvh) * 64) * VTS; }
    else { kbase = P.kc() + (long)b * SEQ * KCS + head * 64; kstride = KCS; vbase = P.vtC() + (long)((b * 4 + head) * 64) * VTS; krbase = P.z() + (long)b * SEQ * IN_COLS + OFF_CKR; }
    int kt_lo = 0, kt_hi = 32;
    if (TYPE == 1) {
        kt_lo = qbA * (2 * NQT) - 2; if (kt_lo < 0) kt_lo = 0; kt_hi = qbB * (2 * NQT) + 2 * NQT + 2; if (kt_hi > 32) kt_hi = 32;
    }

    const bf16_t* krp = (TYPE == 2) ? krbase : nullptr;
    constexpr int BUF = (TYPE == 2) ? 20480 : 16384;
#define ATT_STAGE(buf_, kt_)                                                                             \
    {                                                                                                    \
        char* ls_ = lds + (buf_) * BUF;                                                                  \
        glds_rows128<64>(kbase + (long)((kt_) * 64) * kstride, kstride, ls_, tid);                       \
        glds_rows128<64>(vbase + (kt_) * 64, VTS, ls_ + 8192, tid);                                      \
        if (TYPE == 2) glds_rows64(krp + (long)((kt_) * 64) * IN_COLS, IN_COLS, ls_ + 16384, tid);       \
    }

    const int pr = (r & 0x13) | ((r & 4) << 1) | ((r & 8) >> 1);
    int koff[NS];
#pragma unroll
    for (int s = 0; s < NS; ++s) {
        if (s < 4) koff[s] = pr * 128 + (((2 * s + h) ^ ((pr >> 1) & 7)) << 4);
        else koff[s] = 16384 + pr * 64 + (((2 * (s - 4) + h) ^ ((pr >> 2) & 3)) << 4);
    }
    int voff[2][2];
#pragma unroll
    for (int c = 0; c < 2; ++c)
#pragma unroll
        for (int s2 = 0; s2 < 2; ++s2) voff[c][s2] = 8192 + r * 128 + (((4 * c + 2 * s2 + h) ^ ((r >> 1) & 7)) << 4);

    f32x16 O[NQT][2];
#pragma unroll
    for (int a = 0; a < NQT; ++a)
#pragma unroll
        for (int d = 0; d < 2; ++d)
#pragma unroll
            for (int i = 0; i < 16; ++i) O[a][d][i] = 0.f;
    constexpr bool MT = true;
    constexpr bool MSH = (TYPE == 2);
    constexpr int NM = MSH ? 1 : NQT;
    float m[NQT], lsum[NQT];
#pragma unroll
    for (int a = 0; a < NQT; ++a) {
        if (TYPE == 1) { m[a] = P.b_sink[l * 6 + head] * LOG2E; lsum[a] = (h == 0) ? 1.f : 0.f; }
        else if (MT) { m[a] = 0.f; lsum[a] = 0.f; }
        else { m[a] = -INFINITY; lsum[a] = 0.f; }
    }
    f32x16 Mneg[NM];
    if (MT) {
#pragma unroll
        for (int a = 0; a < NM; ++a)
#pragma unroll
            for (int i = 0; i < 16; ++i) Mneg[a][i] = -m[a];
    }

    constexpr bool PAIR = (TYPE != 2);
    ATT_STAGE(0, kt_lo);
    if (kt_lo + 1 < kt_hi) ATT_STAGE(1, kt_lo + 1);
    int cur = 0, nx2 = 2;
    for (int kt = kt_lo; kt < kt_hi; ++kt) {
        const char* lb;
        if (PAIR) {
            const int it = kt - kt_lo;
            if ((it & 1) == 0) {
                asm volatile("s_waitcnt vmcnt(0)" ::: "memory");
                __builtin_amdgcn_s_barrier();
                asm volatile("" ::: "memory");
                if (kt + 2 < kt_hi) { ATT_STAGE((it + 2) & 3, kt + 2); if (kt + 3 < kt_hi) ATT_STAGE((it + 3) & 3, kt + 3); }
            }
            lb = lds + (it & 3) * BUF;
        } else {
            if (kt + 1 < kt_hi) { if (wid < 4) asm volatile("s_waitcnt vmcnt(3)" ::: "memory"); else asm volatile("s_waitcnt vmcnt(2)" ::: "memory"); }
            else asm volatile("s_waitcnt vmcnt(0)" ::: "memory");
            __builtin_amdgcn_s_barrier();
            asm volatile("" ::: "memory");
            if (kt + 2 < kt_hi) ATT_STAGE(nx2, kt + 2);
            lb = lds + cur * BUF;
            cur = (cur == 2) ? 0 : cur + 1;
            nx2 = (nx2 == 2) ? 0 : nx2 + 1;
        }
        bool active = true;
        if (TYPE == 1) active = (kt * 64 + 63 >= q0 - 128) && (kt * 64 <= q0 + 32 * NQT - 1 + 128);
#pragma unroll
        for (int c = 0; c < 2; ++c) {
            if (active) {
#pragma unroll
                for (int qt = 0; qt < NQT; ++qt) {
                    bool need_mask = false;
                    if (TYPE == 1) {
                        const int qlo = q0 + qt * 32, klo = kt * 64 + c * 32;
                        if (klo - (qlo + 31) > 128 || qlo - (klo + 31) > 128) continue;
                        need_mask = (klo + 31 - qlo > 128) || (qlo + 31 - klo > 128);
                    }
                    f32x16 S;
                    if (MT) S = Mneg[MSH ? 0 : qt];
                    else {
#pragma unroll
                        for (int i = 0; i < 16; ++i) S[i] = 0.f;
                    }
#pragma unroll
                    for (int s = 0; s < NS; ++s) {
                        const bf16x8 kf = *(const bf16x8*)(lb + koff[s] + c * ((s < 4) ? 4096 : 2048));
                        S = MFMA32(kf, qf[qt][s], S);
                    }
                    if (TYPE == 1 && need_mask) {
                        const int qpos = q0 + qt * 32 + r;
                        const int kb0 = kt * 64 + c * 32 + 8 * h;
#pragma unroll
                        for (int i = 0; i < 16; ++i) {
                            const int key = kb0 + (i & 3) + 4 * ((i >> 2) & 1) + 16 * (i >> 3);
                            const int d = qpos - key;
                            if (d > 128 || d < -128) S[i] = -1e30f;
                        }
                    }
                    float mx = 0.f;
                    if (TYPE != 0 || !skipmax) {
                        mx = S[0];
#pragma unroll
                        for (int i = 1; i < 16; ++i) mx = fmaxf(mx, S[i]);
                        mx = xhalf_max(mx);
                    }
                    if (MT) {
                        if ((TYPE != 0 || !skipmax) && __builtin_amdgcn_ballot_w64(mx > 6.0f) != 0) {
                            const float dlt = fmaxf(mx, 0.f);
                            const float alpha = __builtin_amdgcn_exp2f(-dlt);
                            if (MSH) {
                                m[0] += dlt;
#pragma unroll
                                for (int a = 0; a < NQT; ++a) {
                                    lsum[a] *= alpha;
#pragma unroll
                                    for (int d = 0; d < 2; ++d)
#pragma unroll
                                        for (int i = 0; i < 16; ++i) O[a][d][i] *= alpha;
                                }
#pragma unroll
                                for (int i = 0; i < 16; ++i) { S[i] -= dlt; Mneg[0][i] = -m[0]; }
                            } else {
                                m[qt] += dlt;
                                lsum[qt] *= alpha;
#pragma unroll
                                for (int d = 0; d < 2; ++d)
#pragma unroll
                                    for (int i = 0; i < 16; ++i) O[qt][d][i] *= alpha;
#pragma unroll
                                for (int i = 0; i < 16; ++i) { S[i] -= dlt; Mneg[qt][i] = -m[qt]; }
                            }
                        }
                    } else if (__builtin_amdgcn_ballot_w64(mx - m[qt] > 6.0f) != 0) {
                        const float mnew = fmaxf(m[qt], mx);
                        const float alpha = __builtin_amdgcn_exp2f(m[qt] - mnew);
                        m[qt] = mnew;
                        lsum[qt] *= alpha;
#pragma unroll
                        for (int d = 0; d < 2; ++d)
#pragma unroll
                            for (int i = 0; i < 16; ++i) O[qt][d][i] *= alpha;
                    }
                    const float mcur = MT ? 0.f : m[qt];
                    float rs = 0.f;
#pragma unroll
                    for (int i = 0; i < 16; ++i) { const float p = __builtin_amdgcn_exp2f(MT ? S[i] : S[i] - mcur); S[i] = p; rs += p; }
                    lsum[qt] += rs;
#pragma unroll
                    for (int s2 = 0; s2 < 2; ++s2) {
                        u32x4 pp;
#pragma unroll
                        for (int k = 0; k < 4; ++k) pp[k] = pk2(S[8 * s2 + 2 * k], S[8 * s2 + 2 * k + 1]);
                        const bf16x8 pf = __builtin_bit_cast(bf16x8, pp);
#pragma unroll
                        for (int dvt = 0; dvt < 2; ++dvt) {
                            const bf16x8 vf = *(const bf16x8*)(lb + voff[c][s2] + dvt * 4096);
                            O[qt][dvt] = MFMA32(vf, pf, O[qt][dvt]);
                        }
                    }
                }
            }
        }
    }
    __syncthreads();

    bf16_t* og = P.xb();
    {
        const int tid2 = opaque_tid(P.wv), r2 = tid2 & 31, h2 = (tid2 >> 5) & 1;
        const int head = (tid2 >> 8) ? headB : headA, qb = (tid2 >> 8) ? qbB : qbA;
        const int q02 = qb * (128 * NQT) + ((tid2 >> 6) & 3) * (32 * NQT);
#pragma unroll
        for (int qt = 0; qt < NQT; ++qt) {
            const float lt = xhalf_sum(lsum[qt]);
            const float inv = __builtin_amdgcn_rcpf(lt);
            const long tok = (long)b * SEQ + q02 + qt * 32 + r2;
            const bf16_t* gp = P.z() + tok * IN_COLS + ((TYPE == 0) ? OFF_AG : (TYPE == 1) ? OFF_BG : OFF_CG) + head * 64;
            bf16_t* op = og + tok * LDX + ((TYPE == 0) ? 0 : (TYPE == 1) ? 384 : 768) + head * 64;
            u32x2 graw[2][4];
#pragma unroll
            for (int dvt = 0; dvt < 2; ++dvt)
#pragma unroll
                for (int g4 = 0; g4 < 4; ++g4) graw[dvt][g4] = *(const u32x2*)(gp + dvt * 32 + 8 * g4 + 4 * h2);
#pragma unroll
            for (int dvt = 0; dvt < 2; ++dvt)
#pragma unroll
                for (int g4 = 0; g4 < 4; ++g4) {
                    const int dv = dvt * 32 + 8 * g4 + 4 * h2;
                    const float gv0 = bflo(graw[dvt][g4][0]), gv1 = bfhi(graw[dvt][g4][0]), gv2 = bflo(graw[dvt][g4][1]), gv3 = bfhi(graw[dvt][g4][1]);
                    const float o0 = O[qt][dvt][4 * g4 + 0] * inv * (gv0 * __builtin_amdgcn_rcpf(1.0f + __expf(-gv0)));
                    const float o1 = O[qt][dvt][4 * g4 + 1] * inv * (gv1 * __builtin_amdgcn_rcpf(1.0f + __expf(-gv1)));
                    const float o2 = O[qt][dvt][4 * g4 + 2] * inv * (gv2 * __builtin_amdgcn_rcpf(1.0f + __expf(-gv2)));
                    const float o3 = O[qt][dvt][4 * g4 + 3] * inv * (gv3 * __builtin_amdgcn_rcpf(1.0f + __expf(-gv3)));
                    u32x2 o; o[0] = pk2(o0, o1); o[1] = pk2(o2, o3);
                    *(u32x2*)(op + dv) = o;
                }
        }
    }
#undef ATT_STAGE
}

DI void phase_attn(const Params& P, int l, char* lds, volatile unsigned* sh_idx, int rep) {
    const int x = blockIdx.x & 7;
    unsigned* ctr = P.bar() + XCD_BAR_WORDS + (l * 8 + x) * 16 + rep * 8;
    for (;;) {
        __syncthreads();
        if (opaque_tid(P.wv) == 0) *sh_idx = atomicAdd(ctr, 1u);
        __syncthreads();
        const int q = (int)__builtin_amdgcn_readfirstlane(*sh_idx);
        if (q >= 128) break;
        if (q < 32) { const int b = 2 * x + (q >> 4), v = q & 15, head = v & 3, qbp = v >> 2; attn_item<2, 2>(P, l, b, 0, head, 2 * qbp, head, 2 * qbp + 1, lds); }
        else {
            const int u = (q < 80) ? q - 32 : q - 80, b = 2 * x + u / 24, w = u % 24, kvh = w / 12, w2 = w % 12, qbp = w2 / 3, j = w2 % 3;
            const int hA = kvh * 3 + ((j == 1) ? 2 : 0), hB = kvh * 3 + ((j == 1) ? 2 : 1);
            const int qA = 2 * qbp + ((j == 2) ? 1 : 0), qB = 2 * qbp + ((j == 0) ? 0 : 1);
            if (q < 80) attn_item<0, 2>(P, l, b, kvh, hA, qA, hB, qB, lds);
            else attn_item<1, 2>(P, l, b, kvh, hA, qA, hB, qB, lds);
        }
    }
}

constexpr int N_PHASES = 13;
DI void run_phase(const Params& P, int ph, char* lds, volatile unsigned* sh_idx, int rep = 0) {
    if (ph == 0) { phase_prep(P); phase_norm<false>(P.x, P.xb(), nullptr, nullptr, P.wv); return; }
    if (ph == 12) { phase_norm<true>(P.out, nullptr, P.out, P.final_g, P.wv); return; }
    const int l = (ph >= 6) ? 1 : 0;
    const int sub = ph - 6 * l;
    if (sub == 0) return;
    if (sub == 1) {
        GemmArgs g{(l == 0) ? P.xb() : P.xb2(), LDX, P.winT() + (long)l * IN_PAD * LDW, LDW, 1024, P.wv};
        EpiZ epi{P.z(), P.vtA(), P.vtB(), P.a_kn + l * 64, P.t32(), (l == 0) ? nullptr : P.psum()};
        for_items(128 * 11, [&](int t) { gemm_tile8(g, (t / 11) * 256, (t % 11) * 256, lds, epi); });
        return;
    }
    if (sub == 2) return;
    if (sub == 3) {
        GemmArgs gq{P.z() + OFF_CQ, IN_COLS, P.wuqT() + (long)l * 512 * 192, 192, 192, P.wv};
        GemmArgs gk{P.z() + OFF_CKV, IN_COLS, P.wukvT() + (long)l * 512 * 128, 128, 128, P.wv};
        EpiQC eq{P.qc()};
        EpiKV ek{P.kc(), P.vtC()};
        for_items(128 * 4, [&](int t) {
            const int mt = t >> 2, n = t & 3;
            {
                const int tid = opaque_tid(P.wv), row = tid >> 1, half = tid & 1, ncols = (n < 2) ? 192 : 128;
                const bf16_t* p = P.z() + (long)(mt * 256 + row) * IN_COLS + ((n < 2) ? OFF_CQ : OFF_CKV) + half * (ncols >> 1);
                u32x4 raw[12];
#pragma unroll
                for (int c = 0; c < 8; ++c) raw[c] = *(const u32x4*)(p + c * 8);
#pragma unroll
                for (int c = 8; c < 12; ++c) raw[c] = (u32x4){0u, 0u, 0u, 0u};
                if (n < 2) {
#pragma unroll
                    for (int c = 8; c < 12; ++c) raw[c] = *(const u32x4*)(p + c * 8);
                }
                float ss = 0.f;
#pragma unroll
                for (int c = 0; c < 12; ++c) {
                    float w[8]; unpack8(raw[c], w);
#pragma unroll
                    for (int j = 0; j < 8; ++j) ss += w[j] * w[j];
                }
                ss += __shfl_xor(ss, 1);
                if (half == 0) ((float*)(lds + LDS_RINV))[row] = rsqrtf(ss / (float)ncols + EPS);
            }
            if (n < 2) gemm_tile(gq, mt * 256, n * 256, lds, eq);
            else gemm_tile(gk, mt * 256, (n - 2) * 256, lds, ek);
        });
        return;
    }
    if (sub == 4) { phase_attn(P, l, lds, sh_idx, rep); return; }
    if (sub == 5) {
        GemmArgs g{P.xb(), LDX, P.woutT() + (long)l * 1024 * LDW, LDW, 1024, P.wv};
        EpiOut epi{(l == 0) ? P.x : P.out, P.out, (l == 0) ? P.xb2() : nullptr, P.psum()};
        for_items(128 * 4, [&](int t) { gemm_tile8(g, (t >> 2) * 256, (t & 3) * 256, lds, epi); });
        return;
    }
}

template <bool COOP>
__global__ void __launch_bounds__(NT, 2) mega(Params P, int plo, int phi) {
    extern __shared__ __attribute__((aligned(16))) char lds[];
    volatile unsigned* xw = (volatile unsigned*)(lds + LDS_RING);
    volatile unsigned* sh_idx = xw + 2;
    Params Q = P;
    Q.wv = __builtin_amdgcn_readfirstlane((int)threadIdx.x >> 6);
    if (COOP) {
        if (opaque_tid(Q.wv) == 0) { xw[0] = 0u; xw[1] = 0u; xw[2] = 0u; xw[3] = 0u; }
        __syncthreads();
        XcdBarrier xb = xcd_barrier_post(Q.bar(), (volatile LAS unsigned*)(lds + LDS_RING), Q.wv);
        for (int ph = plo; ph < phi; ++ph) {
            if (ph == 2 || ph == 8 || ph == 6) continue;
            run_phase(Q, ph, lds, sh_idx);
            if ((REP_MASK >> ph) & 1) { xcd_barrier(xb); run_phase(Q, ph, lds, sh_idx, 1); }
            if (ph + 1 < phi) {
                if (plo < 0) cg::this_grid().sync();
                xcd_barrier(xb);
            }
        }
    } else {
        for (int ph = plo; ph < phi; ++ph) run_phase(Q, ph, lds, sh_idx);
    }
}

extern "C" void kernel_launch(void* const* d_in, const int* in_sizes, int n_in, void* d_out, int out_size, void* d_ws, size_t ws_size, hipStream_t stream) {
    Params P{};
    P.x = (const float*)d_in[0]; P.norm_g = (const float*)d_in[1]; P.w_in = (const float*)d_in[2]; P.a_qn = (const float*)d_in[3];
    P.a_kn = (const float*)d_in[4]; P.b_sink = (const float*)d_in[5]; P.c_qn = (const float*)d_in[6]; P.c_kvn = (const float*)d_in[7];
    P.c_wuq = (const float*)d_in[8]; P.c_wukv = (const float*)d_in[9]; P.w_out = (const float*)d_in[10]; P.final_g = (const float*)d_in[11];
    P.out = (float*)d_out;
    P.ws = (char*)d_ws;
    if (WS_TOTAL > ws_size) { fprintf(stderr, "workspace too small: need %zu have %zu\n", (size_t)WS_TOTAL, ws_size); return; }

    static int grid_blocks = 0;
    if (!grid_blocks) {
        int dev = 0, cus = 0, per_cu = 0;
        hipGetDevice(&dev);
        hipDeviceGetAttribute(&cus, hipDeviceAttributeMultiprocessorCount, dev);
#if MK_COOP
        hipFuncSetAttribute((const void*)mega<true>, hipFuncAttributeMaxDynamicSharedMemorySize, LDS_BYTES);
        hipOccupancyMaxActiveBlocksPerMultiprocessor(&per_cu, mega<true>, NT, LDS_BYTES);
#else
        hipFuncSetAttribute((const void*)mega<false>, hipFuncAttributeMaxDynamicSharedMemorySize, LDS_BYTES);
        hipOccupancyMaxActiveBlocksPerMultiprocessor(&per_cu, mega<false>, NT, LDS_BYTES);
#endif
        if (per_cu < 1) per_cu = 1;
        if (per_cu > 1) per_cu = 1;
        grid_blocks = cus * per_cu;
    }
#if MK_COOP
    hipMemsetAsync(P.bar(), 0, (XCD_BAR_WORDS + 512) * 4, stream);
    int plo = 0, phi = N_PHASES;
    void* args[] = {&P, &plo, &phi};
    hipError_t e = hipLaunchCooperativeKernel((void*)mega<true>, dim3(grid_blocks), dim3(NT), args, LDS_BYTES, stream);
    if (e != hipSuccess) fprintf(stderr, "cooperative launch failed: %s (grid %d)\n", hipGetErrorString(e), grid_blocks);
#else
    for (int ph = 0; ph < N_PHASES; ++ph) mega<false><<<dim3(grid_blocks), dim3(NT), LDS_BYTES, stream>>>(P, ph, ph + 1);
#endif
}
```

```cpp
#include <hip/hip_runtime.h>
#include <hip/hip_cooperative_groups.h>
#include <stdint.h>
#include <cstdio>
namespace cg = cooperative_groups;

#ifndef REP_MASK
#define REP_MASK 0
#endif
#ifndef MK_COOP
#define MK_COOP 1
#endif

#define DI __device__ __forceinline__
typedef unsigned short bf16_t;
typedef short bf16x8 __attribute__((ext_vector_type(8)));
typedef float f32x16 __attribute__((ext_vector_type(16)));
typedef unsigned u32x4 __attribute__((ext_vector_type(4)));
typedef unsigned u32x2 __attribute__((ext_vector_type(2)));
typedef __bf16 bf2_t __attribute__((ext_vector_type(2)));
typedef float f2_t __attribute__((ext_vector_type(2)));

constexpr int D_MODEL = 1024, SEQ = 2048, NBATCH = 16, NTOK = NBATCH * SEQ;
constexpr int IN_COLS = 2656, IN_PAD = 2816;
constexpr int NT = 512, NWV = 8;
constexpr int LDS_RING = 131072, LDS_RINV = LDS_RING + 16, LDS_BYTES = LDS_RINV + 1024;
constexpr int LDX = 1088, LDW = 1088, VTS = 2112, KCS = 320;
constexpr int OFF_AV = 0, OFF_BV = 128, OFF_AQ = 256, OFF_AK = 640, OFF_AG = 768, OFF_BQ = 1152, OFF_BK = 1536, OFF_BG = 1664,
              OFF_CQ = 2048, OFF_CKV = 2240, OFF_CKR = 2368, OFF_CG = 2400;
constexpr int T64_OFF = 2048 * 16;
constexpr float EPS = 1e-6f;
constexpr float LOG2E = 1.4426950408889634f;

#define XCD_BAR_WORDS 3456
constexpr size_t wsal(size_t b) { return (b + 255) & ~(size_t)255; }
constexpr size_t WS_xb = 0;
constexpr size_t WS_z = WS_xb + wsal((size_t)NTOK * LDX * 2);
constexpr size_t WS_qc = WS_z + wsal((size_t)NTOK * IN_COLS * 2);
constexpr size_t WS_kc = WS_qc + wsal((size_t)NTOK * 384 * 2);
constexpr size_t WS_vtA = WS_kc + wsal((size_t)NTOK * KCS * 2);
constexpr size_t WS_vtB = WS_vtA + wsal((size_t)NBATCH * 2 * 64 * VTS * 2);
constexpr size_t WS_vtC = WS_vtB + wsal((size_t)NBATCH * 2 * 64 * VTS * 2);
constexpr size_t WS_winT = WS_vtC + wsal((size_t)NBATCH * 4 * 64 * VTS * 2);
constexpr size_t WS_woutT = WS_winT + wsal((size_t)2 * IN_PAD * LDW * 2);
constexpr size_t WS_wuqT = WS_woutT + wsal((size_t)2 * 1024 * LDW * 2);
constexpr size_t WS_wukvT = WS_wuqT + wsal((size_t)2 * 512 * 192 * 2);
constexpr size_t WS_t32 = WS_wukvT + wsal((size_t)2 * 512 * 128 * 2);
constexpr size_t WS_bar = WS_t32 + wsal((size_t)2048 * 48 * 8);
constexpr size_t WS_xb2 = WS_bar + wsal((size_t)(XCD_BAR_WORDS + 512) * 4);
constexpr size_t WS_psum = WS_xb2 + wsal((size_t)NTOK * LDX * 2);
constexpr size_t WS_TOTAL = WS_psum + wsal((size_t)NTOK * 8 * 4);
struct Params {
    const float *x, *norm_g, *w_in, *a_qn, *a_kn, *b_sink, *c_qn, *c_kvn, *c_wuq, *c_wukv, *w_out, *final_g;
    float* out;
    char* ws;
    int wv, pad_;
    __host__ __device__ __forceinline__ bf16_t* xb() const { return (bf16_t*)(ws + WS_xb); }
    __host__ __device__ __forceinline__ bf16_t* z() const { return (bf16_t*)(ws + WS_z); }
    __host__ __device__ __forceinline__ bf16_t* qc() const { return (bf16_t*)(ws + WS_qc); }
    __host__ __device__ __forceinline__ bf16_t* kc() const { return (bf16_t*)(ws + WS_kc); }
    __host__ __device__ __forceinline__ bf16_t* vtA() const { return (bf16_t*)(ws + WS_vtA); }
    __host__ __device__ __forceinline__ bf16_t* vtB() const { return (bf16_t*)(ws + WS_vtB); }
    __host__ __device__ __forceinline__ bf16_t* vtC() const { return (bf16_t*)(ws + WS_vtC); }
    __host__ __device__ __forceinline__ bf16_t* winT() const { return (bf16_t*)(ws + WS_winT); }
    __host__ __device__ __forceinline__ bf16_t* woutT() const { return (bf16_t*)(ws + WS_woutT); }
    __host__ __device__ __forceinline__ bf16_t* wuqT() const { return (bf16_t*)(ws + WS_wuqT); }
    __host__ __device__ __forceinline__ bf16_t* wukvT() const { return (bf16_t*)(ws + WS_wukvT); }
    __host__ __device__ __forceinline__ float2* t32() const { return (float2*)(ws + WS_t32); }
    __host__ __device__ __forceinline__ unsigned* bar() const { return (unsigned*)(ws + WS_bar); }
    __host__ __device__ __forceinline__ bf16_t* xb2() const { return (bf16_t*)(ws + WS_xb2); }
    __host__ __device__ __forceinline__ float* psum() const { return (float*)(ws + WS_psum); }
};

typedef float f4v __attribute__((ext_vector_type(4)));
DI float4 ld_nt(const float* p) { const f4v v = __builtin_nontemporal_load((const f4v*)p); float4 o; o.x = v[0]; o.y = v[1]; o.z = v[2]; o.w = v[3]; return o; }
DI void st_nt(float* p, const float4& o) { f4v v; v[0] = o.x; v[1] = o.y; v[2] = o.z; v[3] = o.w; __builtin_nontemporal_store(v, (f4v*)p); }
DI unsigned pk2(float lo, float hi) { f2_t v = {lo, hi}; return __builtin_bit_cast(unsigned, __builtin_convertvector(v, bf2_t)); }
DI float bflo(unsigned u) { return __uint_as_float(u << 16); }
DI float bfhi(unsigned u) { return __uint_as_float(u & 0xffff0000u); }
DI void unpack8(const u32x4& raw, float* v) {
#pragma unroll
    for (int k = 0; k < 4; ++k) { v[2 * k] = bflo(raw[k]); v[2 * k + 1] = bfhi(raw[k]); }
}
DI u32x4 pack8(const float* v) { u32x4 o; o[0] = pk2(v[0], v[1]); o[1] = pk2(v[2], v[3]); o[2] = pk2(v[4], v[5]); o[3] = pk2(v[6], v[7]); return o; }
DI float wave_sum(float v) {
#pragma unroll
    for (int o = 32; o >= 1; o >>= 1) v += __shfl_xor(v, o);
    return v;
}

DI float xhalf_max(float x) { const auto p = __builtin_amdgcn_permlane32_swap(__float_as_uint(x), __float_as_uint(x), false, false); return fmaxf(__uint_as_float(p[0]), __uint_as_float(p[1])); }
DI float xhalf_sum(float x) { const auto p = __builtin_amdgcn_permlane32_swap(__float_as_uint(x), __float_as_uint(x), false, false); return __uint_as_float(p[0]) + __uint_as_float(p[1]); }
DI int opaque_tid(int wv) { int lane; asm volatile("v_mbcnt_lo_u32_b32 %0, -1, 0\n\tv_mbcnt_hi_u32_b32 %0, -1, %0" : "=v"(lane)); return wv * 64 + lane; }
DI int crow(int i, int h) { return (i & 3) + 8 * (i >> 2) + 4 * h; }

typedef __attribute__((address_space(3))) unsigned lds_u32;
template <int ROWS> DI void glds_rows128(const bf16_t* src, long row_stride, char* img, int tid) {
    const int lane = tid & 63, wid = tid >> 6;
#pragma unroll
    for (int k = 0; k < ROWS / 64; ++k) {
        const int p = wid + NWV * k;
        const int row = p * 8 + (lane >> 3), pc = lane & 7, lc = pc ^ ((row >> 1) & 7);
        __builtin_amdgcn_global_load_lds((const unsigned*)(src + (long)row * row_stride + lc * 8), (lds_u32*)(img + p * 1024 + lane * 16), 16, 0, 0);
    }
}
DI void glds_rows64(const bf16_t* src, long row_stride, char* img, int tid) {
    const int lane = tid & 63, wid = tid >> 6;
    if (wid < 4) {
        const int row = wid * 16 + (lane >> 2), pc = lane & 3, lc = pc ^ ((row >> 2) & 3);
        __builtin_amdgcn_global_load_lds((const unsigned*)(src + (long)row * row_stride + lc * 8), (lds_u32*)(img + wid * 1024 + lane * 16), 16, 0, 0);
    }
}
#define MFMA32(a, b, c) __builtin_amdgcn_mfma_f32_32x32x16_bf16((a), (b), (c), 0, 0, 0)

template <class F> DI void for_items(int total, F f) {
    if ((gridDim.x & 7) == 0 && (total & 7) == 0) {
        const int x = blockIdx.x & 7, j = blockIdx.x >> 3, nb = gridDim.x >> 3, per = total >> 3;
        for (int t = j; t < per; t += nb) f(x * per + t);
    } else {
        for (int t = blockIdx.x; t < total; t += gridDim.x) f(t);
    }
}


template <class F> DI void for_items_dyn(int total, unsigned* heads, volatile unsigned* sh_idx, int wv, F f) {
    const int x = blockIdx.x & 7, per = total >> 3;
    for (;;) {
        __syncthreads();
        if (opaque_tid(wv) == 0) *sh_idx = atomicAdd(heads + x * 16, 1u);
        __syncthreads();
        const int q = (int)__builtin_amdgcn_readfirstlane(*sh_idx);
        if (q >= per) break;
        f(x * per + q);
    }
}

#define XB_TMO      128
#define XB_XCNT(j)  (256  + 64 * (j))
#define XB_XSUB(j)  (1280 + 64 * (j))
#define XB_XGEN(j)  (2304 + 64 * (j))
#define XB_TOP      3328
#define XB_TOPGEN   3392
#define XB_SPIN_CAP (1u << 18)
#define LAS __attribute__((address_space(3)))
DI unsigned xb_ld(unsigned* p)              { return __hip_atomic_load(p, __ATOMIC_RELAXED, __HIP_MEMORY_SCOPE_AGENT); }
DI unsigned xb_add(unsigned* p, unsigned v) { return __hip_atomic_fetch_add(p, v, __ATOMIC_RELAXED, __HIP_MEMORY_SCOPE_AGENT); }
DI unsigned xb_xcc_id() { return (unsigned)__builtin_amdgcn_s_getreg((3 << 11) | 20) & 0xFu; }
#define XB_SPIN(cond, bar) do { unsigned _sp = 0; while (cond) { __builtin_amdgcn_s_sleep(1); \
    if ((++_sp & 255u) == 0u) { if (xb_ld(&(bar)[XB_TMO])) break; if (_sp > XB_SPIN_CAP) { atomicAdd(&(bar)[XB_TMO], 1u); break; } } } } while (0)
struct XcdBarrier { unsigned* bar; unsigned x; volatile LAS unsigned* st; int wv; };
DI XcdBarrier xcd_barrier_post(unsigned* bar, volatile LAS unsigned* st, int wv) {
    XcdBarrier b; b.bar = bar; b.x = xb_xcc_id(); b.st = st; b.wv = wv;
    if (opaque_tid(wv) == 0) (void)xb_add(&bar[XB_XCNT(b.x)], 1u);
    return b;
}
DI void xcd_barrier_complete(unsigned* bar, unsigned x, unsigned& nloc, unsigned& nx) {
    const unsigned G = gridDim.x * gridDim.y * gridDim.z;
    unsigned sum, cnt, mine, sp = 0u;
    for (;;) {
        sum = 0u; cnt = 0u; mine = 0u;
#pragma unroll
        for (unsigned j = 0; j < 16; ++j) { const unsigned c = xb_ld(&bar[XB_XCNT(j)]); sum += c; cnt += (c > 0u) ? 1u : 0u; mine = (j == x) ? c : mine; }
        if (sum == G) break;
        __builtin_amdgcn_s_sleep(1);
        if ((++sp & 255u) == 0u) { if (xb_ld(&bar[XB_TMO])) break; if (sp > XB_SPIN_CAP) { atomicAdd(&bar[XB_TMO], 1u); break; } }
    }
    nloc = mine > 0u ? mine : 1u; nx = cnt > 0u ? cnt : 1u;
}
DI void xcd_barrier(const XcdBarrier& b) {
    asm volatile("s_waitcnt vmcnt(0)" ::: "memory");
    __syncthreads();
    if (opaque_tid(b.wv) == 0) {
        unsigned* bar = b.bar;
        asm volatile("" : "+s"(bar));
        __builtin_amdgcn_s_waitcnt(0);
        unsigned nloc = b.st[0], nx = b.st[1];
        if (nloc == 0u) { xcd_barrier_complete(bar, b.x, nloc, nx); b.st[0] = nloc; b.st[1] = nx; }
        const unsigned old = xb_add(&bar[XB_XSUB(b.x)], 1u);
        const unsigned gen = old / nloc;
        if (old + 1u == (gen + 1u) * nloc) {
            __builtin_amdgcn_fence(__ATOMIC_RELEASE, "agent");
            asm volatile("s_waitcnt vmcnt(0)" ::: "memory");
            const unsigned og = xb_add(&bar[XB_TOP], 1u);
            const unsigned tg = og / nx;
            if (og + 1u == (tg + 1u) * nx) xb_add(&bar[XB_TOPGEN], 1u);
            else XB_SPIN(xb_ld(&bar[XB_TOPGEN]) == tg, bar);
            __builtin_amdgcn_fence(__ATOMIC_ACQUIRE, "agent");
            xb_add(&bar[XB_XGEN(b.x)], 1u);
            asm volatile("s_waitcnt vmcnt(0)" ::: "memory");
        } else {
            XB_SPIN(xb_ld(&bar[XB_XGEN(b.x)]) == gen, bar);
            __builtin_amdgcn_fence(__ATOMIC_ACQUIRE, "agent");
            asm volatile("s_waitcnt vmcnt(0)" ::: "memory");
        }
    }
    __syncthreads();
}

DI int zsrc_col(int n) { if (n < 128) return 512 + n; if (n < 256) return 1536 + (n - 128); const int m = n - 256; return (m < 512) ? m : (m < 1408) ? 640 + (m - 512) : 1664 + (m - 1408); }
template <bool ZPERM> DI void transpose_convert(const float* __restrict__ W, const float* __restrict__ scale, bf16_t* __restrict__ Wt, int K, int N, int Npad, int ldo, long gtid, long gthreads) {
    const int KC = K >> 3;
    const long total = (long)Npad * KC;
    for (long it = gtid; it < total; it += gthreads) {
        const int n = (int)(it % Npad), kc = (int)(it / Npad);
        u32x4 o = {0u, 0u, 0u, 0u};
        if (n < N) {
            float v[8];
            const int ns = ZPERM ? zsrc_col(n) : n;
#pragma unroll
            for (int j = 0; j < 8; ++j) { const int k = kc * 8 + j; float w = W[(long)k * N + ns]; if (scale) w *= scale[k]; v[j] = w; }
            o = pack8(v);
        }
        *(u32x4*)(Wt + (long)n * ldo + kc * 8) = o;
    }
}

DI void phase_prep(const Params& P) {
    const long gtid = (long)blockIdx.x * blockDim.x + opaque_tid(P.wv), gth = (long)gridDim.x * blockDim.x;
    for (int l = 0; l < 2; ++l) {
        transpose_convert<true>(P.w_in + (long)l * 1024 * IN_COLS, P.norm_g + l * 1024, P.winT() + (long)l * IN_PAD * LDW, 1024, IN_COLS, IN_PAD, LDW, gtid, gth);
        transpose_convert<false>(P.w_out + (long)l * 1024 * 1024, nullptr, P.woutT() + (long)l * 1024 * LDW, 1024, 1024, 1024, LDW, gtid, gth);
        transpose_convert<false>(P.c_wuq + (long)l * 192 * 384, P.c_qn + l * 192, P.wuqT() + (long)l * 512 * 192, 192, 384, 512, 192, gtid, gth);
        transpose_convert<false>(P.c_wukv + (long)l * 128 * 512, P.c_kvn + l * 128, P.wukvT() + (long)l * 512 * 128, 128, 512, 512, 128, gtid, gth);
    }
    for (long it = gtid; it < 2048 * 16; it += gth) {
        const int p = (int)(it >> 4), i = (int)(it & 15);
        const float inv = powf(10000.0f, -(float)i / 16.0f);
        const float ang = (float)p * inv;
        float s, c; sincosf(ang, &s, &c);
        P.t32()[it] = make_float2(c, s);
    }
    for (long it = gtid; it < 2048 * 32; it += gth) {
        const int p = (int)(it >> 5), i = (int)(it & 31);
        const float inv = powf(10000.0f, -(float)i / 32.0f);
        const float ang = (float)p * inv;
        float s, c; sincosf(ang, &s, &c);
        P.t32()[T64_OFF + it] = make_float2(c, s);
    }
}

template <bool FINAL> DI void phase_norm(const float* xin, bf16_t* xb, float* outp, const float* g, int wv) {
    const int tid = opaque_tid(wv), lane = tid & 63;
    const int gw = blockIdx.x * NWV + (tid >> 6), nw = gridDim.x * NWV;
    constexpr int RW = 2;
    for (int row0 = gw * RW; row0 < NTOK; row0 += nw * RW) {
        float4 v[RW][4];
#pragma unroll
        for (int u = 0; u < RW; ++u) {
            const float4* p = (const float4*)(xin + (long)(row0 + u) * 1024);
#pragma unroll
            for (int i = 0; i < 4; ++i) v[u][i] = ld_nt((const float*)(p + lane + 64 * i));
        }
        float4 gg[4];
        if (FINAL) {
#pragma unroll
            for (int i = 0; i < 4; ++i) gg[i] = ((const float4*)g)[lane + 64 * i];
        }
#pragma unroll
        for (int u = 0; u < RW; ++u) {
            float ss = 0.f;
#pragma unroll
            for (int i = 0; i < 4; ++i) ss += v[u][i].x * v[u][i].x + v[u][i].y * v[u][i].y + v[u][i].z * v[u][i].z + v[u][i].w * v[u][i].w;
            ss = wave_sum(ss);
            const float rinv = rsqrtf(ss * (1.0f / 1024.0f) + EPS);
            const long row = row0 + u;
#pragma unroll
            for (int i = 0; i < 4; ++i) {
                if (FINAL) {
                    float4 o; o.x = v[u][i].x * rinv * gg[i].x; o.y = v[u][i].y * rinv * gg[i].y; o.z = v[u][i].z * rinv * gg[i].z; o.w = v[u][i].w * rinv * gg[i].w;
                    st_nt(outp + row * 1024 + (lane + 64 * i) * 4, o);
                } else {
                    u32x2 o; o[0] = pk2(v[u][i].x * rinv, v[u][i].y * rinv); o[1] = pk2(v[u][i].z * rinv, v[u][i].w * rinv);
                    *(u32x2*)(xb + row * LDX + (lane + 64 * i) * 4) = o;
                }
            }
        }
    }
}

struct GemmArgs { const bf16_t* A; int lda; const bf16_t* Bt; int ldb; int K; int wv; };

template <class Epi>
DI void gemm_tile(const GemmArgs& g, int m0, int n0, char* lds, const Epi& epi) {
    const int tid = opaque_tid(g.wv), lane = tid & 63, wid = tid >> 6, wm = wid >> 2, wn = wid & 3;
    const int r = lane & 31, h = lane >> 5;
    f32x16 acc[4][2];
#pragma unroll
    for (int a = 0; a < 4; ++a)
#pragma unroll
        for (int b = 0; b < 2; ++b)
#pragma unroll
            for (int i = 0; i < 16; ++i) acc[a][b][i] = 0.f;
    const bf16_t* ap = g.A + (long)m0 * g.lda;
    const bf16_t* bp = g.Bt + (long)n0 * g.ldb;
    const int nk = g.K >> 6;
    glds_rows128<256>(ap, g.lda, lds, tid);
    glds_rows128<256>(bp, g.ldb, lds + 32768, tid);
    __syncthreads();
    int aoff[4], boff[2];
#pragma unroll
    for (int i = 0; i < 4; ++i) aoff[i] = (wm * 128 + i * 32 + r) * 128;
#pragma unroll
    for (int i = 0; i < 2; ++i) boff[i] = 32768 + (wn * 64 + i * 32 + r) * 128;
    const int swz = (r >> 1) & 7;
    for (int kt = 0; kt < nk; ++kt) {
        if (kt + 1 < nk) {
            char* ls = lds + ((kt + 1) & 1) * 65536;
            glds_rows128<256>(ap + (kt + 1) * 64, g.lda, ls, tid);
            glds_rows128<256>(bp + (kt + 1) * 64, g.ldb, ls + 32768, tid);
        }
        const char* st = lds + (kt & 1) * 65536;
#pragma unroll
        for (int s = 0; s < 4; ++s) {
            const int co = ((2 * s + h) ^ swz) << 4;
            bf16x8 af[4], bfr[2];
#pragma unroll
            for (int i = 0; i < 4; ++i) af[i] = *(const bf16x8*)(st + aoff[i] + co);
#pragma unroll
            for (int i = 0; i < 2; ++i) bfr[i] = *(const bf16x8*)(st + boff[i] + co);
#pragma unroll
            for (int a = 0; a < 4; ++a)
#pragma unroll
                for (int b = 0; b < 2; ++b) acc[a][b] = MFMA32(bfr[b], af[a], acc[a][b]);
        }
        __syncthreads();
    }
    epi(acc, lds, m0, n0, tid);
    __syncthreads();
}

DI int img32(int row, int col) { return row * 512 + ((((col >> 3) ^ (row & 31))) << 4) + (col & 7) * 2; }
DI int img16(int row, int col) { return row * 256 + ((((col >> 3) ^ (row & 15))) << 4) + (col & 7) * 2; }
template <bool W32> DI void epi_stage_rm(const f32x16 (&acc)[4][2], char* img, int tid, int cbase, const float* rtab) {
    const int lane = tid & 63, wid = tid >> 6, wm = wid >> 2, r = lane & 31, h = lane >> 5;
#pragma unroll
    for (int a = 0; a < 4; ++a)
#pragma unroll
        for (int b = 0; b < 2; ++b) {
            const int row = wm * 128 + a * 32 + r;
            const float rs = rtab[row];
#pragma unroll
            for (int g4 = 0; g4 < 4; ++g4) {
                const int col = cbase + b * 32 + 8 * g4 + 4 * h;
                u32x2 v; v[0] = pk2(acc[a][b][4 * g4] * rs, acc[a][b][4 * g4 + 1] * rs); v[1] = pk2(acc[a][b][4 * g4 + 2] * rs, acc[a][b][4 * g4 + 3] * rs);
                *(u32x2*)(img + (W32 ? img32(row, col) : img16(row, col))) = v;
            }
        }
}
DI void epi_stage_vt(const f32x16 (&acc)[4][2], char* img, int tid, int nbase, const float* rtab) {
    const int lane = tid & 63, wid = tid >> 6, wm = wid >> 2, r = lane & 31, h = lane >> 5;
#pragma unroll
    for (int a = 0; a < 4; ++a)
#pragma unroll
        for (int b = 0; b < 2; ++b) {
            const int m = wm * 128 + a * 32 + r;
            const float rs = rtab[m];
#pragma unroll
            for (int i = 0; i < 16; ++i) {
                const int n = nbase + b * 32 + crow(i, h);
                *(bf16_t*)(img + img32(n, m)) = (bf16_t)(pk2(acc[a][b][i] * rs, 0.f) & 0xffffu);
            }
        }
}


typedef float f32x4 __attribute__((ext_vector_type(4)));
namespace g8 {
constexpr int BM = 256, BK = 64, HALF = 128, HT = HALF * BK;
DI int lds_byte(int r, int c) { const int st = (r >> 4) * 2 + (c >> 5), rr = r & 15, cc = c & 31, ob = rr * 64 + cc * 2; return st * 1024 + (ob ^ (((ob >> 9) & 1) << 5)); }
DI void stage_rc(int b, int& R, int& C) { const int st = b / 1024, sb = b % 1024, swz = sb ^ (((sb >> 9) & 1) << 5); R = (st >> 1) * 16 + swz / 64; C = (st & 1) * 32 + (swz % 64) / 2; }
}
template <class Epi>
DI void gemm_tile8(const GemmArgs& g, int m0, int n0, char* lds, const Epi& epi) {
    using namespace g8;
    const bf16_t* A = g.A; const bf16_t* Bt = g.Bt;
    const long lda = g.lda, ldb = g.ldb;
    const int tid = opaque_tid(g.wv);
    const int wid = tid >> 6, lane = tid & 63, wr = wid >> 2, wc = wid & 3, fr = lane & 15, fq = lane >> 4;
    const int lane_off = lds_byte(fr, fq * 8);
    const char* a_rd = lds + wr * 8192 + lane_off;
    const char* b_rd = lds + 65536 + wc * 4096 + lane_off;
    int sr, sc; stage_rc(tid * 16, sr, sc);
    const unsigned a_src = (unsigned)((sr * (int)lda + sc) * 2);
    const unsigned b_src = (unsigned)((sr * (int)ldb + sc) * 2);
    char* st_dst = lds + tid * 16;
#define SA(b, h) (((b) * 2 + (h)) * 16384)
#define SB(b, h) (65536 + ((b) * 2 + (h)) * 16384)
#define STAGE(P_, BASE, LD, br, kt) do { const char* _gb = (const char*)((BASE) + (long)(br) * (LD) + (long)(kt) * BK); const unsigned _so = (&(BASE) == &A) ? a_src : b_src; \
    _Pragma("unroll") for (int _i = 0; _i < 2; ++_i) \
      __builtin_amdgcn_global_load_lds((const unsigned*)(_gb + (size_t)(_so + (unsigned)(_i * 128 * (int)(LD)))), (lds_u32*)(st_dst + (P_) + _i * 8192), 16, 0, 0); } while (0)
#define LDA(dst, b, h) _Pragma("unroll") for (int m = 0; m < 4; ++m) _Pragma("unroll") for (int k = 0; k < 2; ++k) \
    dst[m][k] = *reinterpret_cast<const bf16x8*>(a_rd + SA(b, h) + (2 * m + k) * 1024)
#define LDB(dst, b, h) _Pragma("unroll") for (int n = 0; n < 2; ++n) _Pragma("unroll") for (int k = 0; k < 2; ++k) \
    dst[n][k] = *reinterpret_cast<const bf16x8*>(b_rd + (SB(b, h) - 65536) + (2 * n + k) * 1024)
#define MMA(ai, bj, At_, Bt_) do { __builtin_amdgcn_s_setprio(1); \
    _Pragma("unroll") for (int m = 0; m < 4; ++m) _Pragma("unroll") for (int n = 0; n < 2; ++n) _Pragma("unroll") for (int k = 0; k < 2; ++k) \
      acc[ai][bj][m][n] = __builtin_amdgcn_mfma_f32_16x16x32_bf16(Bt_[n][k], At_[m][k], acc[ai][bj][m][n], 0, 0, 0); \
    __builtin_amdgcn_s_setprio(0); } while (0)
#define WAIT_V(n) asm volatile("s_waitcnt vmcnt(" #n ")" ::: "memory")
#define WAIT_L(n) asm volatile("s_waitcnt lgkmcnt(" #n ")" ::: "memory")
#define BAR __builtin_amdgcn_s_barrier()
#define SCHED __builtin_amdgcn_sched_barrier(0)
    const int brow = m0, bcol = n0;
    f32x4 acc[2][2][4][2];
#pragma unroll
    for (int a = 0; a < 2; ++a)
#pragma unroll
        for (int b = 0; b < 2; ++b)
#pragma unroll
            for (int m = 0; m < 4; ++m)
#pragma unroll
                for (int n = 0; n < 2; ++n) acc[a][b][m][n] = (f32x4){0.f, 0.f, 0.f, 0.f};
    bf16x8 At[4][2], B0[2][2], B1[2][2];
    const int nt = g.K / BK;
    STAGE(SB(0, 0), Bt, ldb, bcol, 0); STAGE(SA(0, 0), A, lda, brow, 0);
    STAGE(SB(0, 1), Bt, ldb, bcol + HALF, 0); STAGE(SA(0, 1), A, lda, brow + HALF, 0);
    if (wr == 1) BAR;
    WAIT_V(4); BAR;
    STAGE(SB(1, 0), Bt, ldb, bcol, 1); STAGE(SA(1, 0), A, lda, brow, 1); STAGE(SB(1, 1), Bt, ldb, bcol + HALF, 1);
    WAIT_V(6); BAR;
    for (int t = 0; t < nt - 2; t += 2) {
        LDB(B0, 0, 0); SCHED; LDA(At, 0, 0); STAGE(SA(1, 1), A, lda, brow + HALF, t + 1);
        WAIT_L(8); BAR; WAIT_L(0); MMA(0, 0, At, B0); BAR; SCHED;
        LDB(B1, 0, 1); STAGE(SB(0, 0), Bt, ldb, bcol, t + 2);
        BAR; WAIT_L(0); MMA(0, 1, At, B1); BAR;
        LDA(At, 0, 1); STAGE(SA(0, 0), A, lda, brow, t + 2);
        BAR; WAIT_L(0); MMA(1, 0, At, B0); BAR; SCHED;
        STAGE(SB(0, 1), Bt, ldb, bcol + HALF, t + 2);
        WAIT_V(6); BAR; MMA(1, 1, At, B1); BAR;
        LDB(B0, 1, 0); SCHED; LDA(At, 1, 0); STAGE(SA(0, 1), A, lda, brow + HALF, t + 2);
        WAIT_L(8); BAR; WAIT_L(0); MMA(0, 0, At, B0); BAR; SCHED;
        LDB(B1, 1, 1); STAGE(SB(1, 0), Bt, ldb, bcol, t + 3);
        BAR; WAIT_L(0); MMA(0, 1, At, B1); BAR;
        LDA(At, 1, 1); STAGE(SA(1, 0), A, lda, brow, t + 3);
        BAR; WAIT_L(0); MMA(1, 0, At, B0); BAR; SCHED;
        STAGE(SB(1, 1), Bt, ldb, bcol + HALF, t + 3);
        WAIT_V(6); BAR; MMA(1, 1, At, B1); BAR;
    }
    { LDB(B0, 0, 0); LDA(At, 0, 0); STAGE(SA(1, 1), A, lda, brow + HALF, nt - 1);
      BAR; WAIT_L(0); MMA(0, 0, At, B0); BAR;
      LDB(B1, 0, 1); BAR; WAIT_L(0); MMA(0, 1, At, B1); BAR;
      LDA(At, 0, 1); WAIT_V(4); BAR; WAIT_L(0); MMA(1, 0, At, B0); MMA(1, 1, At, B1); BAR; }
    { LDB(B0, 1, 0); LDA(At, 1, 0); WAIT_V(2); BAR; WAIT_L(0); MMA(0, 0, At, B0); BAR;
      LDB(B1, 1, 1); WAIT_V(0); BAR; WAIT_L(0); MMA(0, 1, At, B1); BAR;
      LDA(At, 1, 1); BAR; WAIT_L(0); MMA(1, 0, At, B0); MMA(1, 1, At, B1); BAR; }
    if (wr == 0) BAR;
#undef SA
#undef SB
#undef STAGE
#undef LDA
#undef LDB
#undef MMA
#undef WAIT_V
#undef WAIT_L
#undef BAR
#undef SCHED
    __syncthreads();
    epi(acc, lds, m0, n0, opaque_tid(g.wv));
    __syncthreads();
}
DI void epi8_stage_rm(const f32x4 (&acc)[2][2][4][2], char* img, int tid, const float* rinv) {
    const int wid = tid >> 6, lane = tid & 63, wr = wid >> 2, wc = wid & 3, fr = lane & 15, fq = lane >> 4;
#pragma unroll
    for (int ai = 0; ai < 2; ++ai)
#pragma unroll
        for (int bj = 0; bj < 2; ++bj)
#pragma unroll
            for (int m = 0; m < 4; ++m)
#pragma unroll
                for (int n = 0; n < 2; ++n) {
                    const int row = ai * 128 + wr * 64 + m * 16 + fr, col = bj * 128 + wc * 32 + n * 16 + fq * 4;
                    const f32x4 a = acc[ai][bj][m][n] * rinv[row];
                    u32x2 v; v[0] = pk2(a[0], a[1]); v[1] = pk2(a[2], a[3]);
                    *(u32x2*)(img + img32(row, col)) = v;
                }
}
DI void epi8_stage_vt(const f32x4 (&acc)[2][2][4][2], char* img, int tid, const float* rinv) {
    const int wid = tid >> 6, lane = tid & 63, wr = wid >> 2, wc = wid & 3, fr = lane & 15, fq = lane >> 4;
#pragma unroll
    for (int ai = 0; ai < 2; ++ai)
#pragma unroll
        for (int bj = 0; bj < 2; ++bj)
#pragma unroll
            for (int m = 0; m < 4; ++m)
#pragma unroll
                for (int n = 0; n < 2; ++n) {
                    const int row = ai * 128 + wr * 64 + m * 16 + fr, col = bj * 128 + wc * 32 + n * 16 + fq * 4;
                    const f32x4 a = acc[ai][bj][m][n] * rinv[row];
#pragma unroll
                    for (int j = 0; j < 4; ++j) *(bf16_t*)(img + img32(col + j, row)) = (bf16_t)(pk2(a[j], 0.f) & 0xffffu);
                }
}

DI u32x4 kside_chunk(const char* lds, int row, int chbase, int c, int kind, int t, const float* akn, const float2* tab) {
    const char* rp = lds + row * 512;
    const int sw = row & 31;
    float v[8], pv[8];
    const int pc = (kind == 2) ? (c ^ 4) : (c ^ 2);
    unpack8(*(const u32x4*)(rp + (((chbase + c) ^ sw) << 4)), v);
    unpack8(*(const u32x4*)(rp + (((chbase + pc) ^ sw) << 4)), pv);
    if (kind == 1) {
        float ss = 0.f;
#pragma unroll
        for (int cc = 0; cc < 8; ++cc) {
            float w[8]; unpack8(*(const u32x4*)(rp + (((chbase + cc) ^ sw) << 4)), w);
#pragma unroll
            for (int j = 0; j < 8; ++j) ss += w[j] * w[j];
        }
        const float rinv = rsqrtf(ss * (1.0f / 64.0f) + EPS);
#pragma unroll
        for (int j = 0; j < 8; ++j) { v[j] *= rinv * akn[c * 8 + j]; pv[j] *= rinv * akn[pc * 8 + j]; }
    }
    int tidx; bool first;
    if (kind == 1) { const int pos = (c < 4) ? (t >> 6) : (t & 63); tidx = pos * 16 + (c & 1) * 8; first = !(c & 2); }
    else if (kind == 2) { tidx = T64_OFF + t * 32 + (c & 3) * 8; first = (c < 4); }
    else { tidx = t * 16 + (c & 1) * 8; first = !(c & 2); }
    float o[8];
#pragma unroll
    for (int j = 0; j < 8; ++j) { const float2 cs = tab[tidx + j]; o[j] = v[j] * cs.x + (first ? -pv[j] : pv[j]) * cs.y; }
    return pack8(o);
}

struct EpiZ {
    bf16_t *z, *vtA, *vtB; const float* akn; const float2* tab; const float* psum;
    DI void operator()(const f32x4 (&acc)[2][2][4][2], char* lds, int m0, int n0, int tid) const {
        float* rl = (float*)(lds + LDS_RINV);
        if (tid < 256) {
            float rv = 1.0f;
            if (psum) {
                const float4* pp = (const float4*)(psum + (long)(m0 + tid) * 8);
                const float4 p0 = pp[0], p1 = pp[1];
                rv = rsqrtf(((p0.x + p0.y) + (p0.z + p0.w) + (p1.x + p1.y) + (p1.z + p1.w)) * (1.0f / 1024.0f) + EPS);
            }
            rl[tid] = rv;
        }
        __syncthreads();
        if (n0 == 0) {
            epi8_stage_vt(acc, lds, tid, rl);
            __syncthreads();
            const int b = m0 >> 11, t0 = m0 & 2047;
#pragma unroll
            for (int k = 0; k < 16; ++k) {
                const int idx = tid + NT * k, n = idx >> 5, ch = idx & 31;
                const u32x4 v = *(const u32x4*)(lds + n * 512 + ((ch ^ (n & 31)) << 4));
                bf16_t* vt = (n < 128) ? vtA : vtB;
                *(u32x4*)(vt + (long)(b * 128 + (n & 127)) * VTS + t0 + ch * 8) = v;
            }
        } else {
            epi8_stage_rm(acc, lds, tid, rl);
            __syncthreads();
            const int ch_limit = (IN_COLS - n0) >> 3;
            const int kind = (n0 == 512) ? 1 : (n0 == 1536) ? 2 : (n0 == 2304) ? 3 : 0;
            const int klo = (kind == 1) ? 16 : (kind == 3) ? 8 : 0, khi = (kind == 1) ? 32 : (kind == 2) ? 16 : (kind == 3) ? 12 : 0;
#pragma unroll
            for (int k = 0; k < 16; ++k) {
                const int idx = tid + NT * k, row = idx >> 5, ch = idx & 31;
                const u32x4 v = *(const u32x4*)(lds + row * 512 + ((ch ^ (row & 31)) << 4));
                if (ch < ch_limit && !(ch >= klo && ch < khi)) *(u32x4*)(z + (long)(m0 + row) * IN_COLS + n0 + ch * 8) = v;
            }
            if (kind) {
                const int lg = (kind == 3) ? 2 : 4;
                const int per = (256 << lg) / NT;
#pragma unroll 1
                for (int i0 = 0; i0 < per; i0 += 4) {
                    u32x4 o[4]; int rr[4], cc[4];
#pragma unroll
                    for (int u = 0; u < 4; ++u) {
                        const int e = tid + NT * (i0 + u), row = e >> lg, hc = e & ((1 << lg) - 1);
                        rr[u] = row; cc[u] = klo + hc;
                        if (i0 + u < per) o[u] = kside_chunk(lds, row, (kind == 3) ? klo : klo + (hc & ~7), (kind == 3) ? hc : (hc & 7), kind, (m0 + row) & 2047, akn, tab);
                    }
#pragma unroll
                    for (int u = 0; u < 4; ++u)
                        if (i0 + u < per) *(u32x4*)(z + (long)(m0 + rr[u]) * IN_COLS + n0 + cc[u] * 8) = o[u];
                }
            }
        }
    }
};
struct EpiQC {
    bf16_t* qc;
    DI void operator()(const f32x16 (&acc)[4][2], char* lds, int m0, int n0, int tid) const {
        const int wn = (tid >> 6) & 3;
        epi_stage_rm<true>(acc, lds, tid, wn * 64, (const float*)(lds + LDS_RINV));
        __syncthreads();
        const int ch_limit = (384 - n0) >> 3;
#pragma unroll
        for (int k = 0; k < 16; ++k) {
            const int idx = tid + NT * k, row = idx >> 5, ch = idx & 31;
            const u32x4 v = *(const u32x4*)(lds + row * 512 + ((ch ^ (row & 31)) << 4));
            if (ch < ch_limit) *(u32x4*)(qc + (long)(m0 + row) * 384 + n0 + ch * 8) = v;
        }
    }
};
struct EpiKV {
    bf16_t *kc, *vtC;
    DI void operator()(const f32x16 (&acc)[4][2], char* lds, int m0, int n0, int tid) const {
        const int wn = (tid >> 6) & 3, hl = wn >> 1, head0 = (n0 >> 8) * 2;
        if ((wn & 1) == 0) epi_stage_rm<false>(acc, lds, tid, hl * 64, (const float*)(lds + LDS_RINV));
        else epi_stage_vt(acc, lds + 65536, tid, hl * 64, (const float*)(lds + LDS_RINV));
        __syncthreads();
        const int b = m0 >> 11, t0 = m0 & 2047;
#pragma unroll
        for (int k = 0; k < 8; ++k) {
            const int idx = tid + NT * k, row = idx >> 4, ch = idx & 15;
            const u32x4 v = *(const u32x4*)(lds + row * 256 + ((ch ^ (row & 15)) << 4));
            *(u32x4*)(kc + (long)(m0 + row) * KCS + (head0 + (ch >> 3)) * 64 + (ch & 7) * 8) = v;
        }
#pragma unroll
        for (int k = 0; k < 8; ++k) {
            const int idx = tid + NT * k, n = idx >> 5, ch = idx & 31;
            const u32x4 v = *(const u32x4*)(lds + 65536 + n * 512 + ((ch ^ (n & 31)) << 4));
            *(u32x4*)(vtC + (long)((b * 4 + head0 + (n >> 6)) * 64 + (n & 63)) * VTS + t0 + ch * 8) = v;
        }
    }
};
struct EpiOut {
    const float* xin; float* out; bf16_t* xb2; float* psum;
    DI void operator()(const f32x4 (&acc)[2][2][4][2], char* lds, int m0, int n0, int tid) const {
        const int wid = tid >> 6, lane = tid & 63, wr = wid >> 2, wc = wid & 3, fr = lane & 15, fq = lane >> 4;
#pragma unroll
        for (int p = 0; p < 2; ++p) {
#pragma unroll
            for (int ai = 0; ai < 2; ++ai)
#pragma unroll
                for (int m = 0; m < 4; ++m)
#pragma unroll
                    for (int n = 0; n < 2; ++n) {
                        const int row = ai * 128 + wr * 64 + m * 16 + fr, ch = (wc * 32 + n * 16 + fq * 4) >> 2;
                        const f32x4 a = acc[ai][p][m][n];
                        float4 v; v.x = a[0]; v.y = a[1]; v.z = a[2]; v.w = a[3];
                        *(float4*)(lds + row * 512 + ((ch ^ (row & 31)) << 4)) = v;
                    }
            __syncthreads();
#pragma unroll 1
            for (int k2 = 0; k2 < 2; ++k2) {
                float4 xv[8];
#pragma unroll
                for (int k = 0; k < 8; ++k) { const int idx = tid + NT * (k2 * 8 + k), row = idx >> 5, ch = idx & 31; xv[k] = ld_nt(xin + (long)(m0 + row) * 1024 + n0 + p * 128 + ch * 4); }
#pragma unroll
                for (int k = 0; k < 8; ++k) {
                    const int idx = tid + NT * (k2 * 8 + k), row = idx >> 5, ch = idx & 31;
                    const float4 v = *(const float4*)(lds + row * 512 + ((ch ^ (row & 31)) << 4));
                    float4 o; o.x = xv[k].x + v.x; o.y = xv[k].y + v.y; o.z = xv[k].z + v.z; o.w = xv[k].w + v.w;
                    if (xb2) st_nt(out + (long)(m0 + row) * 1024 + n0 + p * 128 + ch * 4, o);
                    else *(float4*)(out + (long)(m0 + row) * 1024 + n0 + p * 128 + ch * 4) = o;
                    if (xb2) {
                        u32x2 ob; ob[0] = pk2(o.x, o.y); ob[1] = pk2(o.z, o.w);
                        *(u32x2*)(xb2 + (long)(m0 + row) * LDX + n0 + p * 128 + ch * 4) = ob;
                        float ss = o.x * o.x + o.y * o.y + o.z * o.z + o.w * o.w;
                        ss += __shfl_xor(ss, 1); ss += __shfl_xor(ss, 2); ss += __shfl_xor(ss, 4); ss += __shfl_xor(ss, 8); ss += __shfl_xor(ss, 16);
                        if (ch == 0) psum[(long)(m0 + row) * 8 + (n0 >> 8) * 2 + p] = ss;
                    }
                }
            }
            __syncthreads();
        }
    }
};

DI void phase_kprep(const Params& P, int l) {
    const int tid = opaque_tid(P.wv), lane = tid & 63;
    const int gw = blockIdx.x * NWV + (tid >> 6), nw = gridDim.x * NWV;
    constexpr int TK = 4;
    const int grp = (lane < 16) ? 0 : (lane < 32) ? 1 : 2;
    const int c = (grp == 2) ? (lane & 3) : (lane & 7);
    const int off1 = (grp == 0) ? OFF_AK + lane * 8 : (grp == 1) ? OFF_BK + (lane - 16) * 8 : OFF_CKR + (lane & 3) * 8;
    const int hl = lane & 31;
    const bool lo = lane < 32;
    const bool valid2 = lo ? (hl < 24) : (hl < 16);
    const int off2 = (lo ? OFF_CQ : OFF_CKV) + (valid2 ? hl : 0) * 8;
    const bool first = (grp == 1) ? (c < 4) : !(c & 2);
    float kn[8];
#pragma unroll
    for (int j = 0; j < 8; ++j) kn[j] = (grp == 0) ? P.a_kn[l * 64 + c * 8 + j] : 1.0f;
    for (int tok0 = gw * TK; tok0 < NTOK; tok0 += nw * TK) {
        u32x4 raw1[TK], raw2[TK];
        float2 cs[TK][8];
#pragma unroll
        for (int u = 0; u < TK; ++u) {
            const int tok = tok0 + u, t = tok & 2047;
            const bf16_t* zr = P.z() + (long)tok * IN_COLS;
            raw1[u] = *(const u32x4*)(zr + off1);
            raw2[u] = *(const u32x4*)(zr + off2);
            int tidx;
            if (grp == 0) { const int pos = (c < 4) ? (t >> 6) : (t & 63); tidx = pos * 16 + (c & 1) * 8; }
            else if (grp == 1) tidx = T64_OFF + t * 32 + (c & 3) * 8;
            else tidx = t * 16 + (c & 1) * 8;
            const float2* tb = P.t32() + tidx;
#pragma unroll
            for (int j = 0; j < 8; ++j) cs[u][j] = tb[j];
        }
#pragma unroll
        for (int u = 0; u < TK; ++u) {
            bf16_t* zr = P.z() + (long)(tok0 + u) * IN_COLS;
            {
                float v[8]; unpack8(raw1[u], v);
                float ss = 0.f;
#pragma unroll
                for (int j = 0; j < 8; ++j) ss += v[j] * v[j];
                ss += __shfl_xor(ss, 1); ss += __shfl_xor(ss, 2); ss += __shfl_xor(ss, 4);
                if (grp == 0) {
                    const float rinv = rsqrtf(ss * (1.0f / 64.0f) + EPS);
#pragma unroll
                    for (int j = 0; j < 8; ++j) v[j] = v[j] * rinv * kn[j];
                }
                float o[8];
#pragma unroll
                for (int j = 0; j < 8; ++j) {
                    const float p2 = __shfl_xor(v[j], 2), p4 = __shfl_xor(v[j], 4);
                    const float pv = (grp == 1) ? p4 : p2;
                    o[j] = v[j] * cs[u][j].x + (first ? -pv : pv) * cs[u][j].y;
                }
                if (lane < 36) *(u32x4*)(zr + off1) = pack8(o);
            }
            {
                float v[8]; unpack8(raw2[u], v);
                float ss = 0.f;
                if (valid2) {
#pragma unroll
                    for (int j = 0; j < 8; ++j) ss += v[j] * v[j];
                }
                ss += __shfl_xor(ss, 1); ss += __shfl_xor(ss, 2); ss += __shfl_xor(ss, 4); ss += __shfl_xor(ss, 8); ss += __shfl_xor(ss, 16);
                const float rinv = rsqrtf(ss * (lo ? (1.0f / 192.0f) : (1.0f / 128.0f)) + EPS);
#pragma unroll
                for (int j = 0; j < 8; ++j) v[j] *= rinv;
                if (valid2) *(u32x4*)(zr + off2) = pack8(v);
            }
        }
    }
}

template <int TYPE, int NQT>
DI void attn_item(const Params& P, int l, int b, int kvh, int headA, int qbA, int headB, int qbB, char* lds) {
    constexpr int NS = (TYPE == 2) ? 6 : 4;
    const int tid = opaque_tid(P.wv), lane = tid & 63, wid = P.wv, r = lane & 31, h = lane >> 5;
    const int head = (wid >> 2) ? headB : headA, qb = (wid >> 2) ? qbB : qbA;
    const int q0 = qb * (128 * NQT) + (wid & 3) * (32 * NQT);
    const float sc = ((TYPE == 2) ? 0.10206207261596577f : 0.125f) * LOG2E;
    int skipmax = 0;
    if (TYPE == 0) {
        float wq = fabsf(P.a_qn[l * 64 + lane]), wk = fabsf(P.a_kn[l * 64 + lane]);
#pragma unroll
        for (int o = 32; o >= 1; o >>= 1) { wq = fmaxf(wq, __shfl_xor(wq, o)); wk = fmaxf(wk, __shfl_xor(wk, o)); }
        skipmax = __builtin_amdgcn_readfirstlane((8.0f * wq * wk * LOG2E * 1.05f < 30.0f) ? 1 : 0);
    }

    bf16x8 qf[NQT][NS];
#pragma unroll
    for (int qt = 0; qt < NQT; ++qt) {
        const int tq = q0 + qt * 32 + r;
        const long tok = (long)b * SEQ + tq;
        const bf16_t* src = (TYPE == 0) ? P.z() + tok * IN_COLS + OFF_AQ + head * 64 : (TYPE == 1) ? P.z() + tok * IN_COLS + OFF_BQ + head * 64 : P.qc() + tok * 384 + head * 96;
        float qv[NS][8];
#pragma unroll
        for (int s = 0; s < NS; ++s) { const u32x4 raw = *(const u32x4*)(src + 16 * s + 8 * h); unpack8(raw, qv[s]); }
        if (TYPE == 0) {
            float ss = 0.f;
#pragma unroll
            for (int s = 0; s < 4; ++s)
#pragma unroll
                for (int j = 0; j < 8; ++j) ss += qv[s][j] * qv[s][j];
            ss = xhalf_sum(ss);
            const float rinv = rsqrtf(ss * (1.0f / 64.0f) + EPS);
#pragma unroll
            for (int s = 0; s < 4; ++s)
#pragma unroll
                for (int j = 0; j < 8; ++j) qv[s][j] *= rinv * P.a_qn[l * 64 + 16 * s + 8 * h + j];
            const float2* tr = P.t32() + (tq >> 6) * 16 + 8 * h;
            const float2* tc = P.t32() + (tq & 63) * 16 + 8 * h;
#pragma unroll
            for (int j = 0; j < 8; ++j) {
                const float2 a = tr[j], c2 = tc[j];
                const float x0 = qv[0][j], x1 = qv[1][j], y0 = qv[2][j], y1 = qv[3][j];
                qv[0][j] = x0 * a.x - x1 * a.y; qv[1][j] = x1 * a.x + x0 * a.y;
                qv[2][j] = y0 * c2.x - y1 * c2.y; qv[3][j] = y1 * c2.x + y0 * c2.y;
            }
        } else if (TYPE == 1) {
            const float2* t0 = P.t32() + T64_OFF + tq * 32 + 8 * h;
#pragma unroll
            for (int j = 0; j < 8; ++j) {
                const float2 a = t0[j], c2 = t0[16 + j];
                const float x0 = qv[0][j], x1 = qv[2][j], y0 = qv[1][j], y1 = qv[3][j];
                qv[0][j] = x0 * a.x - x1 * a.y; qv[2][j] = x1 * a.x + x0 * a.y;
                qv[1][j] = y0 * c2.x - y1 * c2.y; qv[3][j] = y1 * c2.x + y0 * c2.y;
            }
        } else {
            const float2* t0 = P.t32() + tq * 16 + 8 * h;
#pragma unroll
            for (int j = 0; j < 8; ++j) {
                const float2 a = t0[j];
                const float x0 = qv[NS - 2][j], x1 = qv[NS - 1][j];
                qv[NS - 2][j] = x0 * a.x - x1 * a.y; qv[NS - 1][j] = x1 * a.x + x0 * a.y;
            }
        }
#pragma unroll
        for (int s = 0; s < NS; ++s) {
            float tmp[8];
#pragma unroll
            for (int j = 0; j < 8; ++j) tmp[j] = qv[s][j] * sc;
            qf[qt][s] = __builtin_bit_cast(bf16x8, pack8(tmp));
        }
    }

    const bf16_t* kbase; long kstride; const bf16_t* vbase; const bf16_t* krbase = nullptr;
    if (TYPE == 0) { kbase = P.z() + (long)b * SEQ * IN_COLS + OFF_AK + kvh * 64; kstride = IN_COLS; vbase = P.vtA() + (long)((b * 2 + kvh) * 64) * VTS; }
    else if (TYPE == 1) { kbase = P.z() + (long)b * SEQ * IN_COLS + OFF_BK + kvh * 64; kstride = IN_COLS; vbase = P.vtB() + (long)((b * 2 + kvh) * 64) * VTS; }
    else { kbase = P.kc() + (long)b * SEQ * KCS + head * 64; kstride = KCS; vbase = P.vtC() + (long)((b * 4 + head) * 64) * VTS; krbase = P.z() + (long)b * SEQ * IN_COLS + OFF_CKR; }
    int kt_lo = 0, kt_hi = 32;
    if (TYPE == 1) {
        kt_lo = qbA * (2 * NQT) - 2; if (kt_lo < 0) kt_lo = 0; kt_hi = qbB * (2 * NQT) + 2 * NQT + 2; if (kt_hi > 32) kt_hi = 32;
    }

    const bf16_t* krp = (TYPE == 2) ? krbase : nullptr;
    constexpr int BUF = (TYPE == 2) ? 20480 : 16384;
#define ATT_STAGE(buf_, kt_)                                                                             \
    {                                                                                                    \
        char* ls_ = lds + (buf_) * BUF;                                                                  \
        glds_rows128<64>(kbase + (long)((kt_) * 64) * kstride, kstride, ls_, tid);                       \
        glds_rows128<64>(vbase + (kt_) * 64, VTS, ls_ + 8192, tid);                                      \
        if (TYPE == 2) glds_rows64(krp + (long)((kt_) * 64) * IN_COLS, IN_COLS, ls_ + 16384, tid);       \
    }

    const int pr = (r & 0x13) | ((r & 4) << 1) | ((r & 8) >> 1);
    int koff[NS];
#pragma unroll
    for (int s = 0; s < NS; ++s) {
        if (s < 4) koff[s] = pr * 128 + (((2 * s + h) ^ ((pr >> 1) & 7)) << 4);
        else koff[s] = 16384 + pr * 64 + (((2 * (s - 4) + h) ^ ((pr >> 2) & 3)) << 4);
    }
    int voff[2][2];
#pragma unroll
    for (int c = 0; c < 2; ++c)
#pragma unroll
        for (int s2 = 0; s2 < 2; ++s2) voff[c][s2] = 8192 + r * 128 + (((4 * c + 2 * s2 + h) ^ ((r >> 1) & 7)) << 4);

    f32x16 O[NQT][2];
#pragma unroll
    for (int a = 0; a < NQT; ++a)
#pragma unroll
        for (int d = 0; d < 2; ++d)
#pragma unroll
            for (int i = 0; i < 16; ++i) O[a][d][i] = 0.f;
    constexpr bool MT = true;
    constexpr bool MSH = (TYPE == 2);
    constexpr int NM = MSH ? 1 : NQT;
    float m[NQT], lsum[NQT];
#pragma unroll
    for (int a = 0; a < NQT; ++a) {
        if (TYPE == 1) { m[a] = P.b_sink[l * 6 + head] * LOG2E; lsum[a] = (h == 0) ? 1.f : 0.f; }
        else if (MT) { m[a] = 0.f; lsum[a] = 0.f; }
        else { m[a] = -INFINITY; lsum[a] = 0.f; }
    }
    f32x16 Mneg[NM];
    if (MT) {
#pragma unroll
        for (int a = 0; a < NM; ++a)
#pragma unroll
            for (int i = 0; i < 16; ++i) Mneg[a][i] = -m[a];
    }

    constexpr bool PAIR = (TYPE != 2);
    ATT_STAGE(0, kt_lo);
    if (kt_lo + 1 < kt_hi) ATT_STAGE(1, kt_lo + 1);
    int cur = 0, nx2 = 2;
    for (int kt = kt_lo; kt < kt_hi; ++kt) {
        const char* lb;
        if (PAIR) {
            const int it = kt - kt_lo;
            if ((it & 1) == 0) {
                asm volatile("s_waitcnt vmcnt(0)" ::: "memory");
                __builtin_amdgcn_s_barrier();
                asm volatile("" ::: "memory");
                if (kt + 2 < kt_hi) { ATT_STAGE((it + 2) & 3, kt + 2); if (kt + 3 < kt_hi) ATT_STAGE((it + 3) & 3, kt + 3); }
            }
            lb = lds + (it & 3) * BUF;
        } else {
            if (kt + 1 < kt_hi) { if (wid < 4) asm volatile("s_waitcnt vmcnt(3)" ::: "memory"); else asm volatile("s_waitcnt vmcnt(2)" ::: "memory"); }
            else asm volatile("s_waitcnt vmcnt(0)" ::: "memory");
            __builtin_amdgcn_s_barrier();
            asm volatile("" ::: "memory");
            if (kt + 2 < kt_hi) ATT_STAGE(nx2, kt + 2);
            lb = lds + cur * BUF;
            cur = (cur == 2) ? 0 : cur + 1;
            nx2 = (nx2 == 2) ? 0 : nx2 + 1;
        }
        bool active = true;
        if (TYPE == 1) active = (kt * 64 + 63 >= q0 - 128) && (kt * 64 <= q0 + 32 * NQT - 1 + 128);
#pragma unroll
        for (int c = 0; c < 2; ++c) {
            if (active) {
#pragma unroll
                for (int qt = 0; qt < NQT; ++qt) {
                    bool need_mask = false;
                    if (TYPE == 1) {
                        const int qlo = q0 + qt * 32, klo = kt * 64 + c * 32;
                        if (klo - (qlo + 31) > 128 || qlo - (klo + 31) > 128) continue;
                        need_mask = (klo + 31 - qlo > 128) || (qlo + 31 - klo > 128);
                    }
                    f32x16 S;
                    if (MT) S = Mneg[MSH ? 0 : qt];
                    else {
#pragma unroll
                        for (int i = 0; i < 16; ++i) S[i] = 0.f;
                    }
#pragma unroll
                    for (int s = 0; s < NS; ++s) {
                        const bf16x8 kf = *(const bf16x8*)(lb + koff[s] + c * ((s < 4) ? 4096 : 2048));
                        S = MFMA32(kf, qf[qt][s], S);
                    }
                    if (TYPE == 1 && need_mask) {
                        const int qpos = q0 + qt * 32 + r;
                        const int kb0 = kt * 64 + c * 32 + 8 * h;
#pragma unroll
                        for (int i = 0; i < 16; ++i) {
                            const int key = kb0 + (i & 3) + 4 * ((i >> 2) & 1) + 16 * (i >> 3);
                            const int d = qpos - key;
                            if (d > 128 || d < -128) S[i] = -1e30f;
                        }
                    }
                    float mx = 0.f;
                    if (TYPE != 0 || !skipmax) {
                        mx = S[0];
#pragma unroll
                        for (int i = 1; i < 16; ++i) mx = fmaxf(mx, S[i]);
                        mx = xhalf_max(mx);
                    }
                    if (MT) {
                        if ((TYPE != 0 || !skipmax) && __builtin_amdgcn_ballot_w64(mx > 6.0f) != 0) {
                            const float dlt = fmaxf(mx, 0.f);
                            const float alpha = __builtin_amdgcn_exp2f(-dlt);
                            if (MSH) {
                                m[0] += dlt;
#pragma unroll
                                for (int a = 0; a < NQT; ++a) {
                                    lsum[a] *= alpha;
#pragma unroll
                                    for (int d = 0; d < 2; ++d)
#pragma unroll
                                        for (int i = 0; i < 16; ++i) O[a][d][i] *= alpha;
                                }
#pragma unroll
                                for (int i = 0; i < 16; ++i) { S[i] -= dlt; Mneg[0][i] = -m[0]; }
                            } else {
                                m[qt] += dlt;
                                lsum[qt] *= alpha;
#pragma unroll
                                for (int d = 0; d < 2; ++d)
#pragma unroll
                                    for (int i = 0; i < 16; ++i) O[qt][d][i] *= alpha;
#pragma unroll
                                for (int i = 0; i < 16; ++i) { S[i] -= dlt; Mneg[qt][i] = -m[qt]; }
                            }
                        }
                    } else if (__builtin_amdgcn_ballot_w64(mx - m[qt] > 6.0f) != 0) {
                        const float mnew = fmaxf(m[qt], mx);
                        const float alpha = __builtin_amdgcn_exp2f(m[qt] - mnew);
                        m[qt] = mnew;
                        lsum[qt] *= alpha;
#pragma unroll
                        for (int d = 0; d < 2; ++d)
#pragma unroll
                            for (int i = 0; i < 16; ++i) O[qt][d][i] *= alpha;
                    }
                    const float mcur = MT ? 0.f : m[qt];
                    float rs = 0.f;
#pragma unroll
                    for (int i = 0; i < 16; ++i) { const float p = __builtin_amdgcn_exp2f(MT ? S[i] : S[i] - mcur); S[i] = p; rs += p; }
                    lsum[qt] += rs;
#pragma unroll
                    for (int s2 = 0; s2 < 2; ++s2) {
                        u32x4 pp;
#pragma unroll
                        for (int k = 0; k < 4; ++k) pp[k] = pk2(S[8 * s2 + 2 * k], S[8 * s2 + 2 * k + 1]);
                        const bf16x8 pf = __builtin_bit_cast(bf16x8, pp);
#pragma unroll
                        for (int dvt = 0; dvt < 2; ++dvt) {
                            const bf16x8 vf = *(const bf16x8*)(lb + voff[c][s2] + dvt * 4096);
                            O[qt][dvt] = MFMA32(vf, pf, O[qt][dvt]);
                        }
                    }
                }
            }
        }
    }
    __syncthreads();

    bf16_t* og = P.xb();
    {
        const int tid2 = opaque_tid(P.wv), r2 = tid2 & 31, h2 = (tid2 >> 5) & 1;
        const int head = (tid2 >> 8) ? headB : headA, qb = (tid2 >> 8) ? qbB : qbA;
        const int q02 = qb * (128 * NQT) + ((tid2 >> 6) & 3) * (32 * NQT);
#pragma unroll
        for (int qt = 0; qt < NQT; ++qt) {
            const float lt = xhalf_sum(lsum[qt]);
            const float inv = __builtin_amdgcn_rcpf(lt);
            const long tok = (long)b * SEQ + q02 + qt * 32 + r2;
            const bf16_t* gp = P.z() + tok * IN_COLS + ((TYPE == 0) ? OFF_AG : (TYPE == 1) ? OFF_BG : OFF_CG) + head * 64;
            bf16_t* op = og + tok * LDX + ((TYPE == 0) ? 0 : (TYPE == 1) ? 384 : 768) + head * 64;
            u32x2 graw[2][4];
#pragma unroll
            for (int dvt = 0; dvt < 2; ++dvt)
#pragma unroll
                for (int g4 = 0; g4 < 4; ++g4) graw[dvt][g4] = *(const u32x2*)(gp + dvt * 32 + 8 * g4 + 4 * h2);
#pragma unroll
            for (int dvt = 0; dvt < 2; ++dvt)
#pragma unroll
                for (int g4 = 0; g4 < 4; ++g4) {
                    const int dv = dvt * 32 + 8 * g4 + 4 * h2;
                    const float gv0 = bflo(graw[dvt][g4][0]), gv1 = bfhi(graw[dvt][g4][0]), gv2 = bflo(graw[dvt][g4][1]), gv3 = bfhi(graw[dvt][g4][1]);
                    const float o0 = O[qt][dvt][4 * g4 + 0] * inv * (gv0 * __builtin_amdgcn_rcpf(1.0f + __expf(-gv0)));
                    const float o1 = O[qt][dvt][4 * g4 + 1] * inv * (gv1 * __builtin_amdgcn_rcpf(1.0f + __expf(-gv1)));
                    const float o2 = O[qt][dvt][4 * g4 + 2] * inv * (gv2 * __builtin_amdgcn_rcpf(1.0f + __expf(-gv2)));
                    const float o3 = O[qt][dvt][4 * g4 + 3] * inv * (gv3 * __builtin_amdgcn_rcpf(1.0f + __expf(-gv3)));
                    u32x2 o; o[0] = pk2(o0, o1); o[1] = pk2(o2, o3);
                    *(u32x2*)(op + dv) = o;
                }
        }
    }
#undef ATT_STAGE
}

DI void phase_attn(const Params& P, int l, char* lds, volatile unsigned* sh_idx, int rep) {
    const int x = blockIdx.x & 7;
    unsigned* ctr = P.bar() + XCD_BAR_WORDS + (l * 8 + x) * 16 + rep * 8;
    for (;;) {
        __syncthreads();
        if (opaque_tid(P.wv) == 0) *sh_idx = atomicAdd(ctr, 1u);
        __syncthreads();
        const int q = (int)__builtin_amdgcn_readfirstlane(*sh_idx);
        if (q >= 128) break;
        if (q < 32) { const int b = 2 * x + (q >> 4), v = q & 15, head = v & 3, qbp = v >> 2; attn_item<2, 2>(P, l, b, 0, head, 2 * qbp, head, 2 * qbp + 1, lds); }
        else {
            const int u = (q < 80) ? q - 32 : q - 80, b = 2 * x + u / 24, w = u % 24, kvh = w / 12, w2 = w % 12, qbp = w2 / 3, j = w2 % 3;
            const int hA = kvh * 3 + ((j == 1) ? 2 : 0), hB = kvh * 3 + ((j == 1) ? 2 : 1);
            const int qA = 2 * qbp + ((j == 2) ? 1 : 0), qB = 2 * qbp + ((j == 0) ? 0 : 1);
            if (q < 80) attn_item<0, 2>(P, l, b, kvh, hA, qA, hB, qB, lds);
            else attn_item<1, 2>(P, l, b, kvh, hA, qA, hB, qB, lds);
        }
    }
}

constexpr int N_PHASES = 13;
DI void run_phase(const Params& P, int ph, char* lds, volatile unsigned* sh_idx, int rep = 0) {
    if (ph == 0) { phase_prep(P); phase_norm<false>(P.x, P.xb(), nullptr, nullptr, P.wv); return; }
    if (ph == 12) { phase_norm<true>(P.out, nullptr, P.out, P.final_g, P.wv); return; }
    const int l = (ph >= 6) ? 1 : 0;
    const int sub = ph - 6 * l;
    if (sub == 0) return;
    if (sub == 1) {
        GemmArgs g{(l == 0) ? P.xb() : P.xb2(), LDX, P.winT() + (long)l * IN_PAD * LDW, LDW, 1024, P.wv};
        EpiZ epi{P.z(), P.vtA(), P.vtB(), P.a_kn + l * 64, P.t32(), (l == 0) ? nullptr : P.psum()};
        for_items(128 * 11, [&](int t) { gemm_tile8(g, (t / 11) * 256, (t % 11) * 256, lds, epi); });
        return;
    }
    if (sub == 2) return;
    if (sub == 3) {
        GemmArgs gq{P.z() + OFF_CQ, IN_COLS, P.wuqT() + (long)l * 512 * 192, 192, 192, P.wv};
        GemmArgs gk{P.z() + OFF_CKV, IN_COLS, P.wukvT() + (long)l * 512 * 128, 128, 128, P.wv};
        EpiQC eq{P.qc()};
        EpiKV ek{P.kc(), P.vtC()};
        for_items(128 * 4, [&](int t) {
            const int mt = t >> 2, n = t & 3;
            {
                const int tid = opaque_tid(P.wv), row = tid >> 1, half = tid & 1, ncols = (n < 2) ? 192 : 128;
                const bf16_t* p = P.z() + (long)(mt * 256 + row) * IN_COLS + ((n < 2) ? OFF_CQ : OFF_CKV) + half * (ncols >> 1);
                u32x4 raw[12];
#pragma unroll
                for (int c = 0; c < 8; ++c) raw[c] = *(const u32x4*)(p + c * 8);
#pragma unroll
                for (int c = 8; c < 12; ++c) raw[c] = (u32x4){0u, 0u, 0u, 0u};
                if (n < 2) {
#pragma unroll
                    for (int c = 8; c < 12; ++c) raw[c] = *(const u32x4*)(p + c * 8);
                }
                float ss = 0.f;
#pragma unroll
                for (int c = 0; c < 12; ++c) {
                    float w[8]; unpack8(raw[c], w);
#pragma unroll
                    for (int j = 0; j < 8; ++j) ss += w[j] * w[j];
                }
                ss += __shfl_xor(ss, 1);
                if (half == 0) ((float*)(lds + LDS_RINV))[row] = rsqrtf(ss / (float)ncols + EPS);
            }
            if (n < 2) gemm_tile(gq, mt * 256, n * 256, lds, eq);
            else gemm_tile(gk, mt * 256, (n - 2) * 256, lds, ek);
        });
        return;
    }
    if (sub == 4) { phase_attn(P, l, lds, sh_idx, rep); return; }
    if (sub == 5) {
        GemmArgs g{P.xb(), LDX, P.woutT() + (long)l * 1024 * LDW, LDW, 1024, P.wv};
        EpiOut epi{(l == 0) ? P.x : P.out, P.out, (l == 0) ? P.xb2() : nullptr, P.psum()};
        for_items(128 * 4, [&](int t) { gemm_tile8(g, (t >> 2) * 256, (t & 3) * 256, lds, epi); });
        return;
    }
}

template <bool COOP>
__global__ void __launch_bounds__(NT, 2) mega(Params P, int plo, int phi) {
    extern __shared__ __attribute__((aligned(16))) char lds[];
    volatile unsigned* xw = (volatile unsigned*)(lds + LDS_RING);
    volatile unsigned* sh_idx = xw + 2;
    Params Q = P;
    Q.wv = __builtin_amdgcn_readfirstlane((int)threadIdx.x >> 6);
    if (COOP) {
        if (opaque_tid(Q.wv) == 0) { xw[0] = 0u; xw[1] = 0u; xw[2] = 0u; xw[3] = 0u; }
        __syncthreads();
        XcdBarrier xb = xcd_barrier_post(Q.bar(), (volatile LAS unsigned*)(lds + LDS_RING), Q.wv);
        for (int ph = plo; ph < phi; ++ph) {
            if (ph == 2 || ph == 8 || ph == 6) continue;
            run_phase(Q, ph, lds, sh_idx);
            if ((REP_MASK >> ph) & 1) { xcd_barrier(xb); run_phase(Q, ph, lds, sh_idx, 1); }
            if (ph + 1 < phi) {
                if (plo < 0) cg::this_grid().sync();
                xcd_barrier(xb);
            }
        }
    } else {
        for (int ph = plo; ph < phi; ++ph) run_phase(Q, ph, lds, sh_idx);
    }
}

extern "C" void kernel_launch(void* const* d_in, const int* in_sizes, int n_in, void* d_out, int out_size, void* d_ws, size_t ws_size, hipStream_t stream) {
    Params P{};
    P.x = (const float*)d_in[0]; P.norm_g = (const float*)d_in[1]; P.w_in = (const float*)d_in[2]; P.a_qn = (const float*)d_in[3];
    P.a_kn = (const float*)d_in[4]; P.b_sink = (const float*)d_in[5]; P.c_qn = (const float*)d_in[6]; P.c_kvn = (const float*)d_in[7];
    P.c_wuq = (const float*)d_in[8]; P.c_wukv = (const float*)d_in[9]; P.w_out = (const float*)d_in[10]; P.final_g = (const float*)d_in[11];
    P.out = (float*)d_out;
    P.ws = (char*)d_ws;
    if (WS_TOTAL > ws_size) { fprintf(stderr, "workspace too small: need %zu have %zu\n", (size_t)WS_TOTAL, ws_size); return; }

    static int grid_blocks = 0;
    if (!grid_blocks) {
        int dev = 0, cus = 0, per_cu = 0;
        hipGetDevice(&dev);
        hipDeviceGetAttribute(&cus, hipDeviceAttributeMultiprocessorCount, dev);
#if MK_COOP
        hipFuncSetAttribute((const void*)mega<true>, hipFuncAttributeMaxDynamicSharedMemorySize, LDS_BYTES);
        hipOccupancyMaxActiveBlocksPerMultiprocessor(&per_cu, mega<true>, NT, LDS_BYTES);
#else
        hipFuncSetAttribute((const void*)mega<false>, hipFuncAttributeMaxDynamicSharedMemorySize, LDS_BYTES);
        hipOccupancyMaxActiveBlocksPerMultiprocessor(&per_cu, mega<false>, NT, LDS_BYTES);
#endif
        if (per_cu < 1) per_cu = 1;
        if (per_cu > 1) per_cu = 1;
        grid_blocks = cus * per_cu;
    }
#if MK_COOP
    hipMemsetAsync(P.bar(), 0, (XCD_BAR_WORDS + 512) * 4, stream);
    int plo = 0, phi = N_PHASES;
    void* args[] = {&P, &plo, &phi};
    hipError_t e = hipLaunchCooperativeKernel((void*)mega<true>, dim3(grid_blocks), dim3(NT), args, LDS_BYTES, stream);
    if (e != hipSuccess) fprintf(stderr, "cooperative launch failed: %s (grid %d)\n", hipGetErrorString(e), grid_blocks);
#else
    for (int ph = 0; ph < N_PHASES; ++ph) mega<false><<<dim3(grid_blocks), dim3(NT), LDS_BYTES, stream>>>(P, ph, ph + 1);
#endif
}
```
